# Optimizing an MI355X kernel written in HIP

```python
import jax, jax.numpy as jnp
from jax import lax
import numpy as np

D_MODEL = 2048
BATCH = 8
SEQ = 2048
DEPTH = 2

N_HEADS = 8
N_KV_HEADS = 2
HEAD_DIM = 128
GQA = N_HEADS // N_KV_HEADS
ATTN_W = N_HEADS * HEAD_DIM
KV_W = N_KV_HEADS * HEAD_DIM
Q_BLOCK = 128
ROPE_THETA = 10000.0
GRID_W = 64
CONV_GROUPS = 8
CONV_W = D_MODEL - ATTN_W
CONV_GROUP_DIM = CONV_W // CONV_GROUPS
CONV_WIDTH = 3
IN_W = ATTN_W + 2 * KV_W + 3 * CONV_W
D_FF_DENSE = 5632
N_EXPERTS = 8
TOP_K = 2
D_FF_EXPERT = 4096
N_DENSE = (DEPTH + 1) // 2
N_MOE = DEPTH // 2
EPS = 1e-6

kernel_name = 'hybrid_attn_shortconv_adaln_moe_encoder'


def rms_norm(x, g):
    xf = x.astype(jnp.float32)
    y = xf * lax.rsqrt(jnp.mean(xf * xf, axis=-1, keepdims=True) + EPS)
    return (y * g.astype(jnp.float32)).astype(x.dtype)


def head_rms_norm(y, g, n_heads):
    b, s, w = y.shape
    hd = w // n_heads
    yh = rms_norm(y.reshape(b, s, n_heads, hd), jnp.ones((hd,), y.dtype))
    return yh.reshape(b, s, w) * g.astype(y.dtype)


def axial_rope_tables(seq):
    rows = seq // GRID_W
    row = jnp.repeat(jnp.arange(rows, dtype=jnp.float32), GRID_W)
    col = jnp.tile(jnp.arange(GRID_W, dtype=jnp.float32), rows)
    quarter = HEAD_DIM // 4
    inv = ROPE_THETA ** (-jnp.arange(quarter, dtype=jnp.float32) / quarter)
    ang_r = row[:, None] * inv
    ang_c = col[:, None] * inv
    ang = jnp.concatenate([ang_r, ang_r, ang_c, ang_c], axis=-1)
    return jnp.cos(ang), jnp.sin(ang)


def rotate_sections(x):
    xs = x.reshape(x.shape[:-1] + (2, 2, HEAD_DIM // 4))
    rot = jnp.stack([-xs[..., 1, :], xs[..., 0, :]], axis=-2)
    return rot.reshape(x.shape)


def apply_rope(x, cos, sin):
    xf = x.astype(jnp.float32)
    y = xf * cos[None, :, None, :] + rotate_sections(xf) * sin[None, :, None, :]
    return y.astype(x.dtype)


def attention_group(q, k, v, cos, sin, q_g, k_g):
    q = apply_rope(rms_norm(q, q_g), cos, sin)
    k = apply_rope(rms_norm(k, k_g), cos, sin)
    b, s = q.shape[:2]
    nblk = s // Q_BLOCK
    qb = q.reshape(b, nblk, Q_BLOCK, N_KV_HEADS, GQA, HEAD_DIM).transpose(1, 0, 2, 3, 4, 5)
    scale = HEAD_DIM ** -0.5

    def block(q_blk):
        sc = jnp.einsum('bqhgd,bkhd->bhgqk', q_blk, k, preferred_element_type=jnp.float32) * scale
        p = jax.nn.softmax(sc, axis=-1).astype(v.dtype)
        return jnp.einsum('bhgqk,bkhd->bqhgd', p, v)

    o = lax.map(block, qb)
    return o.transpose(1, 0, 2, 3, 4, 5).reshape(b, s, ATTN_W)


def short_conv_group(h, gate_b, gate_c, w):
    u = gate_c * h
    up = jnp.pad(u, ((0, 0), (1, 1), (0, 0)))
    y = up[:, :-2] * w[0] + up[:, 1:-1] * w[1] + up[:, 2:] * w[2]
    return gate_b * y


def swiglu(h, w_gate, w_up, w_down):
    return (jax.nn.silu(h @ w_gate) * (h @ w_up)) @ w_down


def moe_swiglu(h, router, w_gate, w_up, w_down):
    b, s, d = h.shape
    t = h.reshape(b * s, d)
    logits = jnp.dot(t, router, preferred_element_type=jnp.float32)
    probs = jax.nn.softmax(logits, axis=-1)
    top_v, top_i = lax.top_k(probs, TOP_K)
    top_v = top_v / jnp.sum(top_v, axis=-1, keepdims=True)
    combine = jnp.sum(jax.nn.one_hot(top_i, N_EXPERTS, dtype=jnp.float32) * top_v[..., None], axis=1).astype(h.dtype)
    out = jnp.zeros_like(t)
    for e in range(N_EXPERTS):
        out = out + combine[:, e:e + 1] * swiglu(t, w_gate[e], w_up[e], w_down[e])
    return out.reshape(b, s, d)


def setup_inputs(seed: int = 0) -> dict:
    key = jax.random.key(seed)
    ks = jax.random.split(key, 24)
    n = lambda k, shape, s: jax.random.normal(k, shape, jnp.float32) * s
    D = D_MODEL
    return {
        'x': n(ks[0], (BATCH, SEQ, D), 1.0),
        'c': n(ks[1], (BATCH, D), 1.0),
        'norm1_g': 1.0 + n(ks[2], (DEPTH, D), 0.02),
        'w_ada': n(ks[3], (DEPTH, D, 6 * D), 0.5 * D ** -0.5),
        'b_ada': n(ks[4], (DEPTH, 6 * D), 0.02),
        'w_in': n(ks[5], (DEPTH, D, IN_W), D ** -0.5),
        'q_norm_g': 1.0 + n(ks[6], (DEPTH, HEAD_DIM), 0.02),
        'k_norm_g': 1.0 + n(ks[7], (DEPTH, HEAD_DIM), 0.02),
        'conv_w': n(ks[8], (DEPTH, CONV_WIDTH, CONV_W), CONV_WIDTH ** -0.5),
        'attn_out_g': 1.0 + n(ks[9], (DEPTH, ATTN_W), 0.02),
        'conv_out_g': 1.0 + n(ks[10], (DEPTH, CONV_W), 0.02),
        'w_out': n(ks[11], (DEPTH, D, D), D ** -0.5),
        'norm2_g': 1.0 + n(ks[12], (DEPTH, D), 0.02),
        'dense_w_gate': n(ks[13], (N_DENSE, D, D_FF_DENSE), D ** -0.5),
        'dense_w_up': n(ks[14], (N_DENSE, D, D_FF_DENSE), D ** -0.5),
        'dense_w_down': n(ks[15], (N_DENSE, D_FF_DENSE, D), D_FF_DENSE ** -0.5),
        'moe_router': n(ks[16], (N_MOE, D, N_EXPERTS), D ** -0.5),
        'moe_w_gate': n(ks[17], (N_MOE, N_EXPERTS, D, D_FF_EXPERT), D ** -0.5),
        'moe_w_up': n(ks[18], (N_MOE, N_EXPERTS, D, D_FF_EXPERT), D ** -0.5),
        'moe_w_down': n(ks[19], (N_MOE, N_EXPERTS, D_FF_EXPERT, D), D_FF_EXPERT ** -0.5),
    }


def reference(x, c, norm1_g, w_ada, b_ada, w_in, q_norm_g, k_norm_g, conv_w, attn_out_g,
              conv_out_g, w_out, norm2_g, dense_w_gate, dense_w_up, dense_w_down,
              moe_router, moe_w_gate, moe_w_up, moe_w_down):
    b, s, _ = x.shape
    cos, sin = axial_rope_tables(s)
    splits = [ATTN_W, ATTN_W + KV_W, ATTN_W + 2 * KV_W,
              ATTN_W + 2 * KV_W + CONV_W, ATTN_W + 2 * KV_W + 2 * CONV_W]
    c_act = jax.nn.silu(c)
    for l in range(DEPTH):
        mod = (c_act @ w_ada[l] + b_ada[l])[:, None, :]
        sh1, sc1, g1, sh2, sc2, g2 = jnp.split(mod, 6, axis=-1)
        h = rms_norm(x, norm1_g[l]) * (1.0 + sc1) + sh1
        p = h @ w_in[l]
        q, k, v, hc, gb, gc = jnp.split(p, splits, axis=-1)
        attn = attention_group(q.reshape(b, s, N_HEADS, HEAD_DIM),
                               k.reshape(b, s, N_KV_HEADS, HEAD_DIM),
                               v.reshape(b, s, N_KV_HEADS, HEAD_DIM),
                               cos, sin, q_norm_g[l], k_norm_g[l])
        conv = short_conv_group(hc, gb, gc, conv_w[l])
        mixed = jnp.concatenate([head_rms_norm(attn, attn_out_g[l], N_HEADS),
                                 head_rms_norm(conv, conv_out_g[l], CONV_GROUPS)], axis=-1)
        x = x + g1 * (mixed @ w_out[l])
        h2 = rms_norm(x, norm2_g[l]) * (1.0 + sc2) + sh2
        if l % 2 == 0:
            i = l // 2
            f = swiglu(h2, dense_w_gate[i], dense_w_up[i], dense_w_down[i])
        else:
            i = l // 2
            f = moe_swiglu(h2, moe_router[i], moe_w_gate[i], moe_w_up[i], moe_w_down[i])
        x = x + g2 * f
    return x
```

```cpp
#include <hip/hip_runtime.h>
#include <hip/hip_bf16.h>
#include <cstdio>
#include <cstdint>

#ifndef MK_MULTI
#define MK_MULTI 0
#endif

#ifndef MK_FP8_MOE
#define MK_FP8_MOE 1
#endif
#ifndef MK_FP8_DUP
#define MK_FP8_DUP 1
#endif
#ifndef MK_FP8_DDN
#define MK_FP8_DDN 1
#endif
#ifndef MK_FP8_QKV
#define MK_FP8_QKV 0
#endif
#ifndef MK_WGM_IN
#define MK_WGM_IN 6
#endif
#ifndef MK_WGM_OUT
#define MK_WGM_OUT 4
#endif
#ifndef MK_WGM_UP
#define MK_WGM_UP 8
#endif
#ifndef MK_WGM_DN
#define MK_WGM_DN 8
#endif
#ifndef MK_UFUSE
#define MK_UFUSE 1
#endif
#ifndef MK_Y8
#define MK_Y8 0
#endif
#ifndef MK_XBF
#define MK_XBF 1
#endif
#ifndef MK_CVP0
#define MK_CVP0 0
#endif
#ifndef MK_CVSPLIT
#define MK_CVSPLIT 1
#endif
#define LAS __attribute__((address_space(3)))
#define GAS __attribute__((address_space(1)))
typedef unsigned short bf16_t;
typedef short bf16x8 __attribute__((ext_vector_type(8)));
typedef short s16x4 __attribute__((ext_vector_type(4)));
typedef float f32x4 __attribute__((ext_vector_type(4)));
typedef float f32x2 __attribute__((ext_vector_type(2)));
typedef float f32x16 __attribute__((ext_vector_type(16)));
typedef unsigned u32x4 __attribute__((ext_vector_type(4)));
typedef unsigned u32x2 __attribute__((ext_vector_type(2)));
typedef int v4i __attribute__((ext_vector_type(4)));
typedef int v8i __attribute__((ext_vector_type(8)));
constexpr float FP8_YSCALE = 16.0f;
constexpr float FP8_WSCALE = 256.0f, FP8_ASCALE = 8.0f, FP8_DESCALE = 1.0f / 2048.0f;
__device__ __forceinline__ float clamp448(float x) { return __builtin_amdgcn_fmed3f(x, -448.0f, 448.0f); }
__device__ __forceinline__ unsigned pk4_fp8(float a, float b, float c, float d) { int r = 0; r = __builtin_amdgcn_cvt_pk_fp8_f32(clamp448(a), clamp448(b), r, false); r = __builtin_amdgcn_cvt_pk_fp8_f32(clamp448(c), clamp448(d), r, true); return (unsigned)r; }

constexpr int BATCH = 8, SEQ = 2048, DM = 2048, M = BATCH * SEQ;
constexpr int NHEAD = 8, NKV = 2, HD = 128, IN_W = 4608;
constexpr int OFF_K = 1024, OFF_V = 1280, OFF_HC = 1536, OFF_GB = 2560, OFF_GC = 3584;
constexpr int QKV_W = 1536;
constexpr int PW = MK_UFUSE ? 3584 : 4608;
constexpr int OFF_U = 1536, OFF_GB2 = MK_UFUSE ? 2560 : 2560;
constexpr int FFD = 5632, NEXP = 8, FFE = 4096;
constexpr int MOE_TILES = 136, MOE_ROWS = MOE_TILES * 256;
constexpr float EPS = 1e-6f;
constexpr int MODW = 6 * DM;

constexpr size_t MiB = 1u << 20;
constexpr size_t WS_CTL = 0, CTL_ZERO_BYTES = 1 * MiB;
constexpr size_t WS_MODP = 1 * MiB;
constexpr size_t WS_MODF = 7 * MiB;
constexpr size_t WS_ROUTE = 8 * MiB;
constexpr size_t RT_SEL = 0, RT_WTS = 64 * 1024, RT_POSOF = 192 * 1024, RT_ROWLIST = 320 * 1024, RT_TS = 512 * 1024;
constexpr size_t WS_WIN8 = 9 * MiB;
constexpr size_t WS_WIN = 16 * MiB;
constexpr size_t WS_WOUT = 52 * MiB;
constexpr size_t WS_DGU = 68 * MiB;
constexpr size_t WS_DDN = 112 * MiB;
constexpr size_t WS_MGU = 134 * MiB;
constexpr size_t WS_MDN = 390 * MiB;
constexpr size_t WS_H = 518 * MiB;
constexpr size_t WS_P = 582 * MiB;
constexpr size_t WS_MIX = 726 * MiB;
constexpr size_t WS_HID = 790 * MiB;
constexpr size_t WS_Y = 1062 * MiB;
constexpr size_t WS_Q = 1198 * MiB;
constexpr size_t WS_KV = 1230 * MiB;
constexpr size_t WS_H8 = 1246 * MiB;
constexpr size_t WS_XR = 1246 * MiB;
constexpr size_t WS_XS = 1310 * MiB;
constexpr size_t WS_END = 1311 * MiB;
static_assert(!(MK_XBF && MK_FP8_QKV), "WS_XR overlays WS_H8");
static_assert(!MK_XBF || MK_FP8_DDN, "the bf16 residual stream is wired for the fp8 dense-down GEMM");
constexpr int CW_BAR = 4096;
constexpr int CW_NCNT = 16384;

constexpr int RING_BYTES = 131072;
constexpr int LDSCTL_OFF = 143360, MISC_OFF = LDSCTL_OFF + 320;
constexpr int LDS_BYTES = 147456;

#define RFL(x) __builtin_amdgcn_readfirstlane(x)
#define LDS_WAIT() asm volatile("s_waitcnt lgkmcnt(0)" ::: "memory")
#define VM_WAIT() asm volatile("s_waitcnt vmcnt(0)" ::: "memory")
#define RLX_AGENT __ATOMIC_RELAXED, __HIP_MEMORY_SCOPE_AGENT

__device__ __forceinline__ unsigned cvt_pk_bf16(float lo, float hi) { unsigned r; asm volatile("v_cvt_pk_bf16_f32 %0, %1, %2" : "=v"(r) : "v"(lo), "v"(hi)); return r; }
__device__ __forceinline__ int lane_id() { int l; asm volatile("v_mbcnt_lo_u32_b32 %0, -1, 0\n\tv_mbcnt_hi_u32_b32 %0, -1, %0" : "=v"(l)); return l; }
__device__ __forceinline__ int opaque_tid_w(int wave_s) { int t = wave_s * 64 + lane_id(); asm volatile("" : "+v"(t)); return t; }
#define opaque_tid() opaque_tid_w(g_wave)
#define MY_TID() (g_wave * 64 + lane_id())
__device__ __forceinline__ float bf_lo(unsigned w) { return __uint_as_float(w << 16); }
__device__ __forceinline__ float bf_hi(unsigned w) { return __uint_as_float(w & 0xffff0000u); }
template <int K> __device__ __forceinline__ float swz_xor(float v) { return __int_as_float(__builtin_amdgcn_ds_swizzle(__float_as_int(v), (K << 10) | 0x1f)); }
__device__ __forceinline__ float half_sum(float v) { v += swz_xor<1>(v); v += swz_xor<2>(v); v += swz_xor<4>(v); v += swz_xor<8>(v); v += swz_xor<16>(v); return v; }
__device__ __forceinline__ float sum16(float v) { v += swz_xor<1>(v); v += swz_xor<2>(v); v += swz_xor<4>(v); v += swz_xor<8>(v); return v; }
__device__ __forceinline__ float wave_sum(float v) {
    v = half_sum(v);
    auto rr = __builtin_amdgcn_permlane32_swap(__float_as_uint(v), __float_as_uint(v), false, false);
    return __uint_as_float(rr[0]) + __uint_as_float(rr[1]);
}

#ifndef MK_NFUSE
#define MK_NFUSE 1
#endif
#ifndef MK_CMBPIPE
#define MK_CMBPIPE 1
#endif
#ifndef MK_WT
#define MK_WT 0
#endif
__device__ __forceinline__ void st16(void* p, u32x4 v) { if (MK_WT) asm volatile("global_store_dwordx4 %0, %1, off sc1" :: "v"(p), "v"(v) : "memory"); else *(u32x4*)p = v; }
__device__ __forceinline__ void st16f(void* p, f32x4 v) { if (MK_WT) asm volatile("global_store_dwordx4 %0, %1, off sc1" :: "v"(p), "v"(v) : "memory"); else *(f32x4*)p = v; }
__device__ __forceinline__ void st8(void* p, u32x2 v) { if (MK_WT) asm volatile("global_store_dwordx2 %0, %1, off sc1" :: "v"(p), "v"(v) : "memory"); else *(u32x2*)p = v; }

namespace pg8 {
constexpr int BM = 256, BK = 64, HALF = 128, HTB = HALF * BK * 2, STAGE_BYTES = 8 * HTB, NXCD = 8;
__host__ __device__ __forceinline__ int lds_byte(int r, int c) { const int st = (r >> 4) * 2 + (c >> 5), rr = r & 15, cc = c & 31, ob = rr * 64 + cc * 2; return st * 1024 + (ob ^ (((ob >> 9) & 1) << 5)); }
__host__ __device__ __forceinline__ void stage_rc(int b, int& R, int& C) { const int st = b / 1024, sb = b % 1024, swz = sb ^ (((sb >> 9) & 1) << 5); R = (st >> 1) * 16 + swz / 64; C = (st & 1) * 32 + (swz % 64) / 2; }
__host__ __device__ __forceinline__ int perm32(int rho) { const int n = rho >> 4, i = rho & 15; return 8 * (i >> 2) + 4 * n + (i & 3); }

struct Unit { int pm, pn, pb; };
struct Gemm { const void* A; const void* Bt; int KB; };

struct StaticOrder {
    int nM, nN, nwg, G, c, WGM;
    __device__ __forceinline__ void init(int nM_, int nN_, int G_, int c_, int wgm = 4) { nM = nM_; nN = nN_; nwg = nM * nN; G = G_; c = c_; WGM = wgm; }
    __device__ __forceinline__ bool next_mn(int i, int& pm, int& pn) const {
        const long L = (long)i * G + c; if (L >= nwg) return false;
        int wgid = (int)L; { const int q = nwg / NXCD, r = nwg % NXCD, xcd = wgid % NXCD, off = wgid / NXCD; wgid = (xcd < r ? xcd * (q + 1) : r * (q + 1) + (xcd - r) * q) + off; }
        const int nig = WGM * nN, gid = wgid / nig, fm = gid * WGM, gsz = (nM - fm) < WGM ? (nM - fm) : WGM;
        pm = fm + ((wgid % nig) % gsz); pn = (wgid % nig) / gsz; return true;
    }
};
struct DenseOrder : StaticOrder {
    __device__ __forceinline__ bool next(int i, Unit& u) const { if (!next_mn(i, u.pm, u.pn)) return false; u.pb = u.pn; return true; }
    __device__ __forceinline__ int arow(const Unit& u, int r) const { return u.pm * BM + r; }
};
struct MoeOrder : StaticOrder {
    int t1, t2, t3, t4, t5, t6, t7; const int* rowlist;
    __device__ __forceinline__ int expert(int pm) const { return (pm >= t1) + (pm >= t2) + (pm >= t3) + (pm >= t4) + (pm >= t5) + (pm >= t6) + (pm >= t7); }
    __device__ __forceinline__ bool next(int i, Unit& u) const { if (!next_mn(i, u.pm, u.pn)) return false; u.pb = __builtin_amdgcn_readfirstlane(expert(u.pm)) * nN + u.pn; return true; }
    __device__ __forceinline__ int arow(const Unit& u, int r) const { return rowlist[u.pm * BM + r]; }
};

template <bool SCALED> struct EpiStoreBf16T {
    static constexpr bool PERM = true;
    bf16_t* O; int ldc; int skip; float scale;
    __device__ __forceinline__ void operator()(const f32x4 (&acc)[2][2][4][2], const Unit& u, int wr, int wc, int fr, int fq) const {
        if (skip) return;
        const int row0 = u.pm * BM + wr * 64 + fr, col0 = u.pn * BM + wc * 32 + 8 * fq;
#pragma unroll
        for (int ai = 0; ai < 2; ++ai)
#pragma unroll
            for (int m = 0; m < 4; ++m) { bf16_t* rowp = O + (size_t)(row0 + ai * HALF + m * 16) * ldc + col0;
#pragma unroll
                for (int bj = 0; bj < 2; ++bj) { f32x4 v0 = acc[ai][bj][m][0], v1 = acc[ai][bj][m][1]; if (SCALED) { v0 = v0 * scale; v1 = v1 * scale; }
                    u32x4 w; w.x = cvt_pk_bf16(v0[0], v0[1]); w.y = cvt_pk_bf16(v0[2], v0[3]); w.z = cvt_pk_bf16(v1[0], v1[1]); w.w = cvt_pk_bf16(v1[2], v1[3]);
                    st16(rowp + bj * HALF, w); } }
    }
};
typedef EpiStoreBf16T<false> EpiStoreBf16;
__device__ __forceinline__ float silu_mul(float g, float u) { return g * __builtin_amdgcn_rcpf(1.0f + __builtin_amdgcn_exp2f(-1.4426950408889634f * g)) * u; }
__device__ __forceinline__ float silu_mul_s(float a, float b, float c1, float kc) {
    float t, p;
    asm("v_mul_f32 %0, %3, %2\n\tv_exp_f32 %0, %0\n\tv_mul_f32 %1, %2, %4\n\ts_nop 0\n\tv_fma_f32 %0, %0, %5, %5\n\tv_rcp_f32 %0, %0\n\ts_nop 1\n\tv_mul_f32 %1, %1, %0"
        : "=&v"(t), "=&v"(p) : "v"(a), "s"(c1), "v"(b), "s"(kc));
    return p;
}
struct EpiSwiGLU {
    static constexpr bool PERM = true;
    bf16_t* O; int ldc;
    __device__ __forceinline__ void operator()(const f32x4 (&acc)[2][2][4][2], const Unit& u, int wr, int wc, int fr, int fq) const {
        const int row0 = u.pm * BM + wr * 64 + fr, col0 = u.pn * HALF + wc * 32 + 8 * fq;
#pragma unroll
        for (int ai = 0; ai < 2; ++ai)
#pragma unroll
            for (int m = 0; m < 4; ++m) { bf16_t* rowp = O + (size_t)(row0 + ai * HALF + m * 16) * ldc + col0;
                const f32x4 g0 = acc[ai][0][m][0], g1 = acc[ai][0][m][1], u0 = acc[ai][1][m][0], u1 = acc[ai][1][m][1];
                u32x4 w; w.x = cvt_pk_bf16(silu_mul(g0[0], u0[0]), silu_mul(g0[1], u0[1])); w.y = cvt_pk_bf16(silu_mul(g0[2], u0[2]), silu_mul(g0[3], u0[3]));
                w.z = cvt_pk_bf16(silu_mul(g1[0], u1[0]), silu_mul(g1[1], u1[1])); w.w = cvt_pk_bf16(silu_mul(g1[2], u1[2]), silu_mul(g1[3], u1[3]));
                *(u32x4*)rowp = w; }
    }
};
template <bool OUT8> struct EpiSwiGLU8T {
    static constexpr bool PERM = true;
    void* O; int ldc; float descale, oscale;
    __device__ __forceinline__ void operator()(const f32x4 (&acc)[2][2][4][2], const Unit& u, int wr, int wc, int fr, int fq) const {
        const int row0 = u.pm * BM + wr * 64 + fr, col0 = u.pn * HALF + wc * 32 + 8 * fq;
        const float c1 = -1.4426950408889634f * descale, kc = 1.0f / (descale * descale * oscale);
#pragma unroll
        for (int ai = 0; ai < 2; ++ai)
#pragma unroll
            for (int m = 0; m < 4; ++m) { const size_t eo = (size_t)(row0 + ai * HALF + m * 16) * ldc + col0;
                const f32x4 a0 = acc[ai][0][m][0], a1 = acc[ai][0][m][1], b0 = acc[ai][1][m][0], b1 = acc[ai][1][m][1];
                if (OUT8) {
                    float s0[4], s1[4];
#pragma unroll
                    for (int j = 0; j < 4; ++j) { s0[j] = silu_mul_s(a0[j], b0[j], c1, kc); s1[j] = silu_mul_s(a1[j], b1[j], c1, kc); }
                    u32x2 w; w.x = pk4_fp8(s0[0], s0[1], s0[2], s0[3]); w.y = pk4_fp8(s1[0], s1[1], s1[2], s1[3]);
                    st8((unsigned char*)O + eo, w); }
                else { const f32x4 g0 = a0 * descale, g1 = a1 * descale, u0 = b0 * (descale * oscale), u1 = b1 * (descale * oscale);
                    u32x4 w; w.x = cvt_pk_bf16(silu_mul(g0[0], u0[0]), silu_mul(g0[1], u0[1])); w.y = cvt_pk_bf16(silu_mul(g0[2], u0[2]), silu_mul(g0[3], u0[3]));
                    w.z = cvt_pk_bf16(silu_mul(g1[0], u1[0]), silu_mul(g1[1], u1[1])); w.w = cvt_pk_bf16(silu_mul(g1[2], u1[2]), silu_mul(g1[3], u1[3]));
                    st16((bf16_t*)O + eo, w); } }
    }
};
typedef EpiSwiGLU8T<true> EpiSwiGLU8;
struct EpiResid {
    static constexpr bool PERM = false;
    const float* base; float* out; const float* gate; float scale;
    __device__ __forceinline__ void operator()(const f32x4 (&acc)[2][2][4][2], const Unit& u, int wr, int wc, int fr, int fq) const {
        const int row0 = u.pm * BM + wr * 64 + fr, col0 = u.pn * BM + wc * 32 + 4 * fq;
        const float* gp = gate + (size_t)(u.pm >> 3) * MODW + col0;
        f32x4 gv[2][2];
#pragma unroll
        for (int bj = 0; bj < 2; ++bj)
#pragma unroll
            for (int n = 0; n < 2; ++n) gv[bj][n] = *(const f32x4*)(gp + bj * HALF + n * 16) * scale;
#pragma unroll
        for (int ai = 0; ai < 2; ++ai)
#pragma unroll
            for (int m = 0; m < 4; ++m) { const size_t off = (size_t)(row0 + ai * HALF + m * 16) * DM + col0;
#pragma unroll
                for (int bj = 0; bj < 2; ++bj)
#pragma unroll
                    for (int n = 0; n < 2; ++n) { const f32x4 x = *(const f32x4*)(base + off + bj * HALF + n * 16); st16f(out + off + bj * HALF + n * 16, x + gv[bj][n] * acc[ai][bj][m][n]); } }
    }
};

struct EpiInProj {
    static constexpr bool PERM = true;
    bf16_t* O;
    __device__ __forceinline__ void operator()(const f32x4 (&acc)[2][2][4][2], const Unit& u, int wr, int wc, int fr, int fq) const {
        const int row0 = u.pm * BM + wr * 64 + fr, lc = wc * 32 + 8 * fq;
        if (u.pn >= 6 && u.pn < 14) {
            const int col0 = OFF_U + (u.pn - 6) * HALF + lc;
#pragma unroll
            for (int ai = 0; ai < 2; ++ai)
#pragma unroll
                for (int m = 0; m < 4; ++m) { const f32x4 v0 = acc[ai][0][m][0] * acc[ai][1][m][0], v1 = acc[ai][0][m][1] * acc[ai][1][m][1];
                    u32x4 w; w.x = cvt_pk_bf16(v0[0], v0[1]); w.y = cvt_pk_bf16(v0[2], v0[3]); w.z = cvt_pk_bf16(v1[0], v1[1]); w.w = cvt_pk_bf16(v1[2], v1[3]);
                    *(u32x4*)(O + (size_t)(row0 + ai * HALF + m * 16) * PW + col0) = w; }
        } else {
            const int col0 = (u.pn < 6 ? u.pn * BM : 2560 + (u.pn - 14) * BM) + lc;
#pragma unroll
            for (int ai = 0; ai < 2; ++ai)
#pragma unroll
                for (int m = 0; m < 4; ++m) { bf16_t* rowp = O + (size_t)(row0 + ai * HALF + m * 16) * PW + col0;
#pragma unroll
                    for (int bj = 0; bj < 2; ++bj) { const f32x4 v0 = acc[ai][bj][m][0], v1 = acc[ai][bj][m][1];
                        u32x4 w; w.x = cvt_pk_bf16(v0[0], v0[1]); w.y = cvt_pk_bf16(v0[2], v0[3]); w.z = cvt_pk_bf16(v1[0], v1[1]); w.w = cvt_pk_bf16(v1[2], v1[3]);
                        *(u32x4*)(rowp + bj * HALF) = w; } }
        }
    }
};
struct EpiStoreFp8 {
    static constexpr bool PERM = true;
    unsigned char* O; int ldc; float scale;
    __device__ __forceinline__ void operator()(const f32x4 (&acc)[2][2][4][2], const Unit& u, int wr, int wc, int fr, int fq) const {
        const int row0 = u.pm * BM + wr * 64 + fr, col0 = u.pn * BM + wc * 32 + 8 * fq;
#pragma unroll
        for (int ai = 0; ai < 2; ++ai)
#pragma unroll
            for (int m = 0; m < 4; ++m) { unsigned char* rowp = O + (size_t)(row0 + ai * HALF + m * 16) * ldc + col0;
#pragma unroll
                for (int bj = 0; bj < 2; ++bj) { const f32x4 v0 = acc[ai][bj][m][0] * scale, v1 = acc[ai][bj][m][1] * scale;
                    u32x2 w; w.x = pk4_fp8(v0[0], v0[1], v0[2], v0[3]); w.y = pk4_fp8(v1[0], v1[1], v1[2], v1[3]);
                    *(u32x2*)(rowp + bj * HALF) = w; } }
    }
};
template <bool BASE_F32> struct EpiResidBf {
    static constexpr bool PERM = true;
    const void* base; bf16_t* out; const float* gate; float scale;
    __device__ __forceinline__ void operator()(const f32x4 (&acc)[2][2][4][2], const Unit& u, int wr, int wc, int fr, int fq) const {
        const int row0 = u.pm * BM + wr * 64 + fr, col0 = u.pn * BM + wc * 32 + 8 * fq;
        const float* gp = gate + (size_t)(u.pm >> 3) * MODW + col0;
        f32x4 gv[2][2];
#pragma unroll
        for (int bj = 0; bj < 2; ++bj)
#pragma unroll
            for (int n = 0; n < 2; ++n) gv[bj][n] = *(const f32x4*)(gp + bj * HALF + n * 4) * scale;
#pragma unroll
        for (int ai = 0; ai < 2; ++ai)
#pragma unroll
            for (int m = 0; m < 4; ++m) { const size_t off = (size_t)(row0 + ai * HALF + m * 16) * DM + col0;
#pragma unroll
                for (int bj = 0; bj < 2; ++bj) { f32x4 x0, x1;
                    if (BASE_F32) { x0 = *(const f32x4*)((const float*)base + off + bj * HALF); x1 = *(const f32x4*)((const float*)base + off + bj * HALF + 4); }
                    else { const u32x4 w = *(const u32x4*)((const bf16_t*)base + off + bj * HALF); x0 = (f32x4){bf_lo(w.x), bf_hi(w.x), bf_lo(w.y), bf_hi(w.y)}; x1 = (f32x4){bf_lo(w.z), bf_hi(w.z), bf_lo(w.w), bf_hi(w.w)}; }
                    const f32x4 y0 = x0 + gv[bj][0] * acc[ai][bj][m][0], y1 = x1 + gv[bj][1] * acc[ai][bj][m][1];
                    u32x4 o; o.x = cvt_pk_bf16(y0[0], y0[1]); o.y = cvt_pk_bf16(y0[2], y0[3]); o.z = cvt_pk_bf16(y1[0], y1[1]); o.w = cvt_pk_bf16(y1[2], y1[3]);
                    *(u32x4*)(out + off + bj * HALF) = o; } }
    }
};

template <bool BASE_F32, bool OUT8> struct EpiResidNorm {
    static constexpr bool PERM = true;
    const void* base; bf16_t* out; const float* gate; float scale;
    const float* gn; const float* mod; int ish, isc;
    void* H; float* xbuf; unsigned* cnt; unsigned* tmo; LAS unsigned char* tb;
    __device__ __forceinline__ void operator()(f32x4 (&acc)[2][2][4][2], const Unit& u, int wr, int wc, int fr, int fq) const {
        const int lane = fq * 16 + fr, wid = wr * 4 + wc;
        LAS float* P = (LAS float*)tb; LAS float* S = P + 1024; LAS unsigned* flag = (LAS unsigned*)(S + 256);
        const int row0 = u.pm * BM + wr * 64 + fr, col0 = u.pn * BM + wc * 32 + 8 * fq; const int b = u.pm >> 3;
        int pbase = (wr * 64 + fr) * 4 + wc, sbase = wr * 64 + fr;
        asm volatile("" : "+v"(pbase), "+v"(sbase));
        {
            const float* gp = gate + (size_t)b * MODW + col0;
            f32x4 gv[2][2];
#pragma unroll
            for (int bj = 0; bj < 2; ++bj)
#pragma unroll
                for (int n = 0; n < 2; ++n) gv[bj][n] = *(const f32x4*)(gp + bj * HALF + n * 4) * scale;
#pragma unroll
            for (int ai = 0; ai < 2; ++ai)
#pragma unroll
                for (int m = 0; m < 4; ++m) { const size_t off = (size_t)(row0 + ai * HALF + m * 16) * DM + col0; float ss = 0.f;
#pragma unroll
                    for (int bj = 0; bj < 2; ++bj) { f32x4 x0, x1;
                        if (BASE_F32) { x0 = *(const f32x4*)((const float*)base + off + bj * HALF); x1 = *(const f32x4*)((const float*)base + off + bj * HALF + 4); }
                        else { const u32x4 w = *(const u32x4*)((const bf16_t*)base + off + bj * HALF); x0 = (f32x4){bf_lo(w.x), bf_hi(w.x), bf_lo(w.y), bf_hi(w.y)}; x1 = (f32x4){bf_lo(w.z), bf_hi(w.z), bf_lo(w.w), bf_hi(w.w)}; }
                        const f32x4 y0 = x0 + gv[bj][0] * acc[ai][bj][m][0], y1 = x1 + gv[bj][1] * acc[ai][bj][m][1];
                        acc[ai][bj][m][0] = y0; acc[ai][bj][m][1] = y1;
                        ss += ((y0[0] * y0[0] + y0[1] * y0[1]) + (y0[2] * y0[2] + y0[3] * y0[3])) + ((y1[0] * y1[0] + y1[1] * y1[1]) + (y1[2] * y1[2] + y1[3] * y1[3])); }
                    ss += swz_xor<16>(ss);
                    { auto rr = __builtin_amdgcn_permlane32_swap(__float_as_uint(ss), __float_as_uint(ss), false, false); ss = __uint_as_float(rr[0]) + __uint_as_float(rr[1]); }
                    if (fq == 0) P[pbase + (ai * HALF + m * 16) * 4] = ss; }
        }
        asm volatile("s_waitcnt lgkmcnt(0)" ::: "memory"); __builtin_amdgcn_s_barrier(); asm volatile("" ::: "memory");
        int row = wid * 32 + (lane & 31);
        asm volatile("" : "+v"(row));
        if (lane < 32) { const f32x4 p = *(const LAS f32x4*)(P + row * 4);
            __hip_atomic_store(xbuf + ((size_t)u.pm * BM + row) * 8 + u.pn, (p[0] + p[1]) + (p[2] + p[3]), __ATOMIC_RELAXED, __HIP_MEMORY_SCOPE_AGENT); }
        asm volatile("s_waitcnt vmcnt(0)" ::: "memory");
        if (lane == 0) (void)__hip_atomic_fetch_add(cnt + 64 * u.pm, 1u, __ATOMIC_RELAXED, __HIP_MEMORY_SCOPE_AGENT);
#pragma unroll
        for (int ai = 0; ai < 2; ++ai)
#pragma unroll
            for (int m = 0; m < 4; ++m) { const size_t off = (size_t)(row0 + ai * HALF + m * 16) * DM + col0;
#pragma unroll
                for (int bj = 0; bj < 2; ++bj) { const f32x4 y0 = acc[ai][bj][m][0], y1 = acc[ai][bj][m][1];
                    u32x4 o; o.x = cvt_pk_bf16(y0[0], y0[1]); o.y = cvt_pk_bf16(y0[2], y0[3]); o.z = cvt_pk_bf16(y1[0], y1[1]); o.w = cvt_pk_bf16(y1[2], y1[3]);
                    *(u32x4*)(out + off + bj * HALF) = o; } }
        if (wid == 0) { unsigned sp = 0u, dead = 0u;
            while ((unsigned)__builtin_amdgcn_readfirstlane((int)__hip_atomic_load(cnt + 64 * u.pm, __ATOMIC_RELAXED, __HIP_MEMORY_SCOPE_AGENT)) < 64u) {
                __builtin_amdgcn_s_sleep(1);
                if ((++sp & 255u) == 0u) { if (__hip_atomic_load(tmo, __ATOMIC_RELAXED, __HIP_MEMORY_SCOPE_AGENT)) { dead = 1u; break; } if (sp > (1u << 18)) { if (lane == 0) atomicAdd(tmo, 1u); dead = 1u; break; } } }
            __builtin_amdgcn_fence(__ATOMIC_ACQUIRE, "agent");
            if (lane == 0) flag[0] = dead; }
        asm volatile("s_waitcnt vmcnt(0) lgkmcnt(0)" ::: "memory"); __builtin_amdgcn_s_barrier(); asm volatile("" ::: "memory");
        if (lane < 32) { const float* sl = xbuf + ((size_t)u.pm * BM + row) * 8; float t = 0.f;
#pragma unroll
            for (int k = 0; k < 8; ++k) t += __hip_atomic_load(sl + k, __ATOMIC_RELAXED, __HIP_MEMORY_SCOPE_AGENT);
            S[row] = rsqrtf(t * (1.0f / DM) + EPS); }
        asm volatile("s_waitcnt vmcnt(0) lgkmcnt(0)" ::: "memory"); __builtin_amdgcn_s_barrier(); asm volatile("" ::: "memory");
        const float* mp = mod + (size_t)b * MODW;
#pragma unroll
        for (int bj = 0; bj < 2; ++bj) {
            f32x4 Am[2], Bm[2];
#pragma unroll
            for (int n = 0; n < 2; ++n) { const int c = col0 + bj * HALF + n * 4;
                Am[n] = *(const f32x4*)(gn + c) * (*(const f32x4*)(mp + isc + c) + 1.0f) * (OUT8 ? FP8_ASCALE : 1.0f); Bm[n] = *(const f32x4*)(mp + ish + c) * (OUT8 ? FP8_ASCALE : 1.0f); }
#pragma unroll
            for (int ai = 0; ai < 2; ++ai)
#pragma unroll
                for (int m = 0; m < 4; ++m) { const int r = ai * HALF + wr * 64 + m * 16 + fr; const float rs = S[sbase + ai * HALF + m * 16]; const size_t off = (size_t)(u.pm * BM + r) * DM + col0 + bj * HALF;
                    const f32x4 h0 = acc[ai][bj][m][0] * rs * Am[0] + Bm[0], h1 = acc[ai][bj][m][1] * rs * Am[1] + Bm[1];
                    if (OUT8) { u32x2 w; w.x = pk4_fp8(h0[0], h0[1], h0[2], h0[3]); w.y = pk4_fp8(h1[0], h1[1], h1[2], h1[3]); *(u32x2*)((unsigned char*)H + off) = w; }
                    else { u32x4 w; w.x = cvt_pk_bf16(h0[0], h0[1]); w.y = cvt_pk_bf16(h0[2], h0[3]); w.z = cvt_pk_bf16(h1[0], h1[1]); w.w = cvt_pk_bf16(h1[2], h1[3]); *(u32x4*)((bf16_t*)H + off) = w; } }
            asm volatile("" ::: "memory"); }
    }
};

template <class Epi, class Sched, bool ALIGN_EPI, bool SP2, bool GATHER, int VAR = 0, bool FP8 = false>
__device__ __forceinline__ void gemm_phase(LAS unsigned char* lds, const Gemm g, const Sched& S, const Epi& E, int g_wave) {
    const int tid = opaque_tid(), wid = __builtin_amdgcn_readfirstlane(tid >> 6), lane = tid & 63, wr = wid >> 2, wc = wid & 3, fr = lane & 15, fq = lane >> 4;
    const int KB = g.KB, nt = KB / (BK * 2);
    int Rr[2], Cc[2];
    unsigned voffB[2];
#pragma unroll
    for (int i = 0; i < 2; ++i) { stage_rc(tid * 16 + i * 8192, Rr[i], Cc[i]); const int Rb = Epi::PERM ? ((Rr[i] & ~31) + perm32(Rr[i] & 31)) : Rr[i]; voffB[i] = (unsigned)(Rb * KB + Cc[i] * 2); }
    const size_t kstep = (size_t)(BK * 2);
    const size_t hstep = (size_t)HALF * KB;
    const size_t tstep = 2 * hstep;
    const unsigned ldsw = (unsigned)wid * 1024u;
    const int aoff = lds_byte(wr * 64 + fr, fq * 8), boff = lds_byte(wc * 32 + fr, fq * 8);
#define PG8_SA(b, h) (((b) * 2 + (h)) * HTB)
#define PG8_SB(b, h) ((4 + (b) * 2 + (h)) * HTB)
#define PG8_STAGE(bufoff, gbase, voff) do { if constexpr (VAR != 3) _Pragma("unroll") for (int _i = 0; _i < 2; ++_i) \
        __builtin_amdgcn_global_load_lds((const unsigned*)((const char*)(gbase) + (voff)[_i]), (LAS unsigned*)(lds + (bufoff) + ldsw + _i * 8192), 16, 0, 0); } while (0)
#define PG8_LDA(dst, b, h) do { if constexpr (FP8) { _Pragma("unroll") for (int m = 0; m < 4; ++m) dst##8[m] = PG8_CAT8(*(const LAS v4i*)(lds + PG8_SA(b, h) + aoff + m * 2048), *(const LAS v4i*)(lds + PG8_SA(b, h) + aoff + m * 2048 + 1024)); } \
    else { _Pragma("unroll") for (int m = 0; m < 4; ++m) _Pragma("unroll") for (int k = 0; k < 2; ++k) dst[m][k] = *(const LAS bf16x8*)(lds + PG8_SA(b, h) + aoff + m * 2048 + k * 1024); } } while (0)
#define PG8_LDB(dst, b, h) do { if constexpr (FP8) { _Pragma("unroll") for (int n = 0; n < 2; ++n) dst##8[n] = PG8_CAT8(*(const LAS v4i*)(lds + PG8_SB(b, h) + boff + n * 2048), *(const LAS v4i*)(lds + PG8_SB(b, h) + boff + n * 2048 + 1024)); } \
    else { _Pragma("unroll") for (int n = 0; n < 2; ++n) _Pragma("unroll") for (int k = 0; k < 2; ++k) dst[n][k] = *(const LAS bf16x8*)(lds + PG8_SB(b, h) + boff + n * 2048 + k * 1024); } } while (0)
#define PG8_X4(v16, m) ((m) == 0 ? __builtin_shufflevector(v16, v16, 0, 1, 2, 3) : (m) == 1 ? __builtin_shufflevector(v16, v16, 4, 5, 6, 7) : (m) == 2 ? __builtin_shufflevector(v16, v16, 8, 9, 10, 11) : __builtin_shufflevector(v16, v16, 12, 13, 14, 15))
#define PG8_W16(c) __builtin_shufflevector(c, c, 0, 1, 2, 3, -1, -1, -1, -1, -1, -1, -1, -1, -1, -1, -1, -1)
#define PG8_I4(v16, c, m) ((m) == 0 ? __builtin_shufflevector(v16, PG8_W16(c), 16, 17, 18, 19, 4, 5, 6, 7, 8, 9, 10, 11, 12, 13, 14, 15) : (m) == 1 ? __builtin_shufflevector(v16, PG8_W16(c), 0, 1, 2, 3, 16, 17, 18, 19, 8, 9, 10, 11, 12, 13, 14, 15) : \
    (m) == 2 ? __builtin_shufflevector(v16, PG8_W16(c), 0, 1, 2, 3, 4, 5, 6, 7, 16, 17, 18, 19, 12, 13, 14, 15) : __builtin_shufflevector(v16, PG8_W16(c), 0, 1, 2, 3, 4, 5, 6, 7, 8, 9, 10, 11, 16, 17, 18, 19))
#define PG8_CAT8(x, y) __builtin_shufflevector(__builtin_bit_cast(v4i, x), __builtin_bit_cast(v4i, y), 0, 1, 2, 3, 4, 5, 6, 7)
#define PG8_MMA(ai, bj, At, Bt) do { if constexpr (VAR == 2) { \
        _Pragma("unroll") for (int m = 0; m < 4; ++m) _Pragma("unroll") for (int k = 0; k < 2; ++k) asm volatile("" :: "v"(At[m][k])); _Pragma("unroll") for (int n = 0; n < 2; ++n) _Pragma("unroll") for (int k = 0; k < 2; ++k) asm volatile("" :: "v"(Bt[n][k])); } \
    else if constexpr (FP8) { __builtin_amdgcn_s_setprio(1); _Pragma("unroll") for (int m = 0; m < 4; ++m) _Pragma("unroll") for (int n = 0; n < 2; ++n) \
        { f32x4 c_ = PG8_X4(acc16[ai][bj][n], m); c_ = __builtin_amdgcn_mfma_scale_f32_16x16x128_f8f6f4(Bt##8[n], At##8[m], c_, 0, 0, 0, 0, 0, 0); acc16[ai][bj][n] = PG8_I4(acc16[ai][bj][n], c_, m); } __builtin_amdgcn_s_setprio(0); } \
    else { __builtin_amdgcn_s_setprio(1); _Pragma("unroll") for (int m = 0; m < 4; ++m) _Pragma("unroll") for (int n = 0; n < 2; ++n) _Pragma("unroll") for (int k = 0; k < 2; ++k) \
        acc[ai][bj][m][n] = __builtin_amdgcn_mfma_f32_16x16x32_bf16(Bt[n][k], At[m][k], acc[ai][bj][m][n], 0, 0, 0); __builtin_amdgcn_s_setprio(0); } } while (0)
#define PG8_WAIT_V(n) asm volatile("s_waitcnt vmcnt(" #n ")" ::: "memory")
#define PG8_WAIT_L(n) asm volatile("s_waitcnt lgkmcnt(" #n ")" ::: "memory")
#define PG8_BAR __builtin_amdgcn_s_barrier()
#define PG8_SCHED __builtin_amdgcn_sched_barrier(0)
    Unit cur, nxt; int ui = 0;
    if (!S.next(0, cur)) return;
    f32x4 acc[2][2][4][2];
    f32x16 acc16[2][2][2];
#pragma unroll
    for (int a = 0; a < 2; ++a)
#pragma unroll
        for (int b = 0; b < 2; ++b)
#pragma unroll
            for (int n = 0; n < 2; ++n) acc16[a][b][n] = f32x16{};
#pragma unroll
    for (int a = 0; a < 2; ++a)
#pragma unroll
        for (int b = 0; b < 2; ++b)
#pragma unroll
            for (int m = 0; m < 4; ++m)
#pragma unroll
                for (int n = 0; n < 2; ++n) acc[a][b][m][n] = (f32x4){0.f, 0.f, 0.f, 0.f};
    bf16x8 At[4][2], B0[2][2], B1[2][2];
    v8i At8[4], B08[2], B18[2];
    unsigned vc0[2], vc1[2], vn0[2], vn1[2];
    const int hA = GATHER ? 0 : (int)hstep, hB = (int)hstep;
    const char* cA; const char* cB = (const char*)g.Bt + (size_t)cur.pb * tstep;
    if constexpr (GATHER) {
        cA = (const char*)g.A;
#pragma unroll
        for (int i = 0; i < 2; ++i) { vc0[i] = (unsigned)(S.arow(cur, Rr[i]) * KB + Cc[i] * 2); vc1[i] = (unsigned)(S.arow(cur, HALF + Rr[i]) * KB + Cc[i] * 2); vn0[i] = vc0[i]; vn1[i] = vc1[i]; }
        asm volatile("" : "+v"(vc0[0]), "+v"(vc0[1]), "+v"(vc1[0]), "+v"(vc1[1]));
    } else {
        cA = (const char*)g.A + (size_t)cur.pm * tstep;
#pragma unroll
        for (int i = 0; i < 2; ++i) { vc0[i] = (unsigned)(Rr[i] * KB + Cc[i] * 2); vc1[i] = vc0[i]; vn0[i] = vc0[i]; vn1[i] = vc0[i]; }
    }
#undef PG8_STAGE
#define PG8_STAGE(bufoff, gbase, soff, voff) do { if constexpr (VAR != 3) { const __amdgpu_buffer_rsrc_t rs_ = __builtin_amdgcn_make_buffer_rsrc((void*)(gbase), 0, 0x7fffffff, 0x00020000); \
        _Pragma("unroll") for (int _i = 0; _i < 2; ++_i) __builtin_amdgcn_raw_ptr_buffer_load_lds(rs_, (LAS void*)(lds + (bufoff) + ldsw + _i * 8192), 16, (int)(voff)[_i], (int)(soff), 0, 0); } } while (0)
    constexpr int KS = BK * 2;
    if constexpr (SP2) {
        PG8_STAGE(PG8_SB(0, 0), cB, 0, voffB); PG8_STAGE(PG8_SB(0, 1), cB, hB, voffB); PG8_STAGE(PG8_SA(0, 0), cA, 0, vc0); PG8_STAGE(PG8_SA(0, 1), cA, hA, vc1);
        PG8_STAGE(PG8_SB(1, 0), cB, KS, voffB); PG8_STAGE(PG8_SA(1, 0), cA, KS, vc0); PG8_STAGE(PG8_SB(1, 1), cB, hB + KS, voffB);
        if (wr == 1) PG8_BAR;
        PG8_WAIT_V(8); PG8_BAR;
        PG8_WAIT_V(6); PG8_BAR;
    } else {
        PG8_STAGE(PG8_SB(0, 0), cB, 0, voffB); PG8_STAGE(PG8_SA(0, 0), cA, 0, vc0); PG8_STAGE(PG8_SB(0, 1), cB, hB, voffB); PG8_STAGE(PG8_SA(0, 1), cA, hA, vc1);
        if (wr == 1) PG8_BAR;
        PG8_WAIT_V(4); PG8_BAR;
        PG8_STAGE(PG8_SB(1, 0), cB, KS, voffB); PG8_STAGE(PG8_SA(1, 0), cA, KS, vc0); PG8_STAGE(PG8_SB(1, 1), cB, hB + KS, voffB);
        PG8_WAIT_V(6); PG8_BAR;
    }
    for (;;) {
        const bool has_next = S.next(ui + 1, nxt);
        const char* nA; const char* nB = has_next ? (const char*)g.Bt + (size_t)nxt.pb * tstep : cB;
        if constexpr (GATHER) {
            nA = cA;
            if (has_next && nxt.pm != cur.pm) {
                const int tid2 = opaque_tid();
#pragma unroll
                for (int i = 0; i < 2; ++i) { int R2, C2; stage_rc(tid2 * 16 + i * 8192, R2, C2); vn0[i] = (unsigned)(S.arow(nxt, R2) * KB + C2 * 2); vn1[i] = (unsigned)(S.arow(nxt, HALF + R2) * KB + C2 * 2); }
                asm volatile("" : "+v"(vn0[0]), "+v"(vn0[1]), "+v"(vn1[0]), "+v"(vn1[1]));
            }
        } else {
            nA = has_next ? (const char*)g.A + (size_t)nxt.pm * tstep : cA;
        }
        for (int t = 0; t < nt; t += 2) {
            const bool last = (t == nt - 2);
            const int k1 = (t + 1) * KS;
            const char* a2 = last ? nA : cA; const char* b2 = last ? nB : cB;
            const int k2 = last ? 0 : (t + 2) * KS, k3 = k2 + KS;
            unsigned w0[2], w1[2];
            if constexpr (GATHER) {
#pragma unroll
                for (int i = 0; i < 2; ++i) { w0[i] = last ? vn0[i] : vc0[i]; w1[i] = last ? vn1[i] : vc1[i]; }
            } else {
#pragma unroll
                for (int i = 0; i < 2; ++i) { w0[i] = vc0[i]; w1[i] = vc0[i]; }
            }
            if constexpr (SP2) {
            PG8_LDB(B0, 0, 0); PG8_LDB(B1, 0, 1); PG8_SCHED; PG8_LDA(At, 0, 0); PG8_STAGE(PG8_SA(1, 1), cA, k1 + hA, vc1);
            PG8_WAIT_V(8); PG8_WAIT_L(0); PG8_BAR; PG8_MMA(0, 0, At, B0); PG8_MMA(0, 1, At, B1); PG8_BAR; PG8_SCHED;
            PG8_LDA(At, 0, 1); PG8_STAGE(PG8_SB(0, 0), b2, k2, voffB); PG8_STAGE(PG8_SB(0, 1), b2, k2 + hB, voffB); PG8_STAGE(PG8_SA(0, 0), a2, k2, w0);
            PG8_WAIT_V(8); PG8_WAIT_L(0); PG8_BAR; PG8_MMA(1, 0, At, B0); PG8_MMA(1, 1, At, B1); PG8_BAR; PG8_SCHED;
            PG8_LDB(B0, 1, 0); PG8_LDB(B1, 1, 1); PG8_SCHED; PG8_LDA(At, 1, 0); PG8_STAGE(PG8_SA(0, 1), a2, k2 + hA, w1);
            PG8_WAIT_V(8); PG8_WAIT_L(0); PG8_BAR; PG8_MMA(0, 0, At, B0); PG8_MMA(0, 1, At, B1); PG8_BAR; PG8_SCHED;
            PG8_LDA(At, 1, 1); PG8_STAGE(PG8_SB(1, 0), b2, k3, voffB); PG8_STAGE(PG8_SB(1, 1), b2, k3 + hB, voffB); PG8_STAGE(PG8_SA(1, 0), a2, k3, w0);
            PG8_WAIT_V(8); PG8_WAIT_L(0); PG8_BAR; PG8_MMA(1, 0, At, B0); PG8_MMA(1, 1, At, B1); PG8_BAR; PG8_SCHED;
            } else {
            PG8_LDB(B0, 0, 0); PG8_SCHED; PG8_LDA(At, 0, 0); PG8_STAGE(PG8_SA(1, 1), cA, k1 + hA, vc1);
            PG8_WAIT_L(8); PG8_BAR; PG8_WAIT_L(0); PG8_MMA(0, 0, At, B0); PG8_BAR; PG8_SCHED;
            PG8_LDB(B1, 0, 1); PG8_STAGE(PG8_SB(0, 0), b2, k2, voffB);
            PG8_BAR; PG8_WAIT_L(0); PG8_MMA(0, 1, At, B1); PG8_BAR;
            PG8_LDA(At, 0, 1); PG8_STAGE(PG8_SA(0, 0), a2, k2, w0);
            PG8_BAR; PG8_WAIT_L(0); PG8_MMA(1, 0, At, B0); PG8_BAR; PG8_SCHED;
            PG8_STAGE(PG8_SB(0, 1), b2, k2 + hB, voffB);
            PG8_WAIT_V(6); PG8_BAR; PG8_MMA(1, 1, At, B1); PG8_BAR;
            PG8_LDB(B0, 1, 0); PG8_SCHED; PG8_LDA(At, 1, 0); PG8_STAGE(PG8_SA(0, 1), a2, k2 + hA, w1);
            PG8_WAIT_L(8); PG8_BAR; PG8_WAIT_L(0); PG8_MMA(0, 0, At, B0); PG8_BAR; PG8_SCHED;
            PG8_LDB(B1, 1, 1); PG8_STAGE(PG8_SB(1, 0), b2, k3, voffB);
            PG8_BAR; PG8_WAIT_L(0); PG8_MMA(0, 1, At, B1); PG8_BAR;
            PG8_LDA(At, 1, 1); PG8_STAGE(PG8_SA(1, 0), a2, k3, w0);
            PG8_BAR; PG8_WAIT_L(0); PG8_MMA(1, 0, At, B0); PG8_BAR; PG8_SCHED;
            PG8_STAGE(PG8_SB(1, 1), b2, k3 + hB, voffB);
            PG8_WAIT_V(6); PG8_BAR; PG8_MMA(1, 1, At, B1); PG8_BAR;
            }
        }
        if constexpr (ALIGN_EPI) { if (wr == 0) PG8_BAR; }
        if constexpr (FP8) {
#pragma unroll
            for (int a = 0; a < 2; ++a)
#pragma unroll
                for (int b = 0; b < 2; ++b)
#pragma unroll
                    for (int n = 0; n < 2; ++n) { acc[a][b][0][n] = PG8_X4(acc16[a][b][n], 0); acc[a][b][1][n] = PG8_X4(acc16[a][b][n], 1); acc[a][b][2][n] = PG8_X4(acc16[a][b][n], 2); acc[a][b][3][n] = PG8_X4(acc16[a][b][n], 3); acc16[a][b][n] = f32x16{}; }
        }
        if constexpr (VAR == 0) E(acc, cur, wr, wc, fr, fq); else { _Pragma("unroll") for (int a_ = 0; a_ < 2; ++a_) _Pragma("unroll") for (int b_ = 0; b_ < 2; ++b_) _Pragma("unroll") for (int m_ = 0; m_ < 4; ++m_) _Pragma("unroll") for (int n_ = 0; n_ < 2; ++n_) asm volatile("" :: "v"(acc[a_][b_][m_][n_])); }
        if (!has_next) break;
#pragma unroll
        for (int a = 0; a < 2; ++a)
#pragma unroll
            for (int b = 0; b < 2; ++b)
#pragma unroll
                for (int m = 0; m < 4; ++m)
#pragma unroll
                    for (int n = 0; n < 2; ++n) acc[a][b][m][n] = (f32x4){0.f, 0.f, 0.f, 0.f};
        cur = nxt; cA = nA; cB = nB; ++ui;
        if constexpr (GATHER) {
#pragma unroll
            for (int i = 0; i < 2; ++i) { vc0[i] = vn0[i]; vc1[i] = vn1[i]; } }
        if constexpr (ALIGN_EPI) { if (wr == 1) PG8_BAR; }
    }
    PG8_WAIT_V(0);
    if constexpr (!ALIGN_EPI) { if (wr == 0) PG8_BAR; }
    PG8_BAR;
#undef PG8_SA
#undef PG8_SB
#undef PG8_STAGE
#undef PG8_LDA
#undef PG8_LDB
#undef PG8_MMA
#undef PG8_CAT8
#undef PG8_X4
#undef PG8_W16
#undef PG8_I4
#undef PG8_WAIT_V
#undef PG8_WAIT_L
#undef PG8_BAR
#undef PG8_SCHED
}
}

namespace attn {
constexpr int D = 128, NW = 8, QBLK = 32, KVBLK = 64;
constexpr float SCALE = 0.088388347648318440f;
constexpr float THR = 8.f;
constexpr int LDQ = 1024, LDKV = 512, LDO = DM;
constexpr size_t SHM_V = KVBLK * D * 2, SHM_K = KVBLK * D * 2, SHM_ATTN = 2 * SHM_V + 2 * SHM_K + NW * 64 * 4;
#define KSWZ(row, colB) ((row) * 256 + ((colB) ^ (((row) & 7) << 4)))
#define SBAR() __builtin_amdgcn_sched_barrier(0)
__device__ __forceinline__ int crow(int r, int hi) { return (r & 3) + 8 * (r >> 2) + 4 * hi; }
__device__ __forceinline__ void partialSM(f32x16& p0, f32x16& p1, float& m_reg, float& mn, float& alpha) {
  constexpr float C = SCALE * 1.4426950408889634f;
  float pmax = p0[0]; for (int r = 1; r < 16; ++r) pmax = fmaxf(pmax, p0[r]); for (int r = 0; r < 16; ++r) pmax = fmaxf(pmax, p1[r]);
  { auto rr = __builtin_amdgcn_permlane32_swap(__float_as_uint(pmax), __float_as_uint(pmax), false, false);
    pmax = fmaxf(__uint_as_float(rr[0]), __uint_as_float(rr[1])); }
  if (__builtin_expect(__all(pmax - m_reg <= THR / SCALE), 1)) { mn = m_reg; alpha = 1.f; }
  else { mn = fmaxf(m_reg, pmax); alpha = __builtin_amdgcn_exp2f((m_reg - mn) * C); m_reg = mn; }
  float mnC = -mn * C;
  for (int r = 0; r < 16; ++r) p0[r] = fmaf(p0[r], C, mnC); for (int r = 0; r < 16; ++r) p1[r] = fmaf(p1[r], C, mnC);
  for (int r = 0; r < 16; ++r) p0[r] = __builtin_amdgcn_exp2f(p0[r]);
}
__device__ __forceinline__ void finishSM(f32x16& p0, f32x16& p1, float alpha, float& l_reg, bf16x8& pa0, bf16x8& pa1, bf16x8& pa2, bf16x8& pa3) {
  for (int r = 0; r < 16; ++r) p1[r] = __builtin_amdgcn_exp2f(p1[r]);
  float ps = 0; for (int r = 0; r < 16; ++r) ps += p0[r]; for (int r = 0; r < 16; ++r) ps += p1[r];
  { auto rr = __builtin_amdgcn_permlane32_swap(__float_as_uint(ps), __float_as_uint(ps), false, false);
    ps = __uint_as_float(rr[0]) + __uint_as_float(rr[1]); }
  l_reg = l_reg * alpha + ps;
#define PK4(P, BASE, OUT) do { unsigned a0 = cvt_pk_bf16(P[BASE + 0], P[BASE + 1]), a1 = cvt_pk_bf16(P[BASE + 2], P[BASE + 3]);   \
    unsigned b0 = cvt_pk_bf16(P[BASE + 4], P[BASE + 5]), b1 = cvt_pk_bf16(P[BASE + 6], P[BASE + 7]);                              \
    auto r0 = __builtin_amdgcn_permlane32_swap(a0, b0, false, false); auto r1 = __builtin_amdgcn_permlane32_swap(a1, b1, false, false); \
    u32x4 w = {r0[0], r1[0], r0[1], r1[1]}; OUT = *reinterpret_cast<bf16x8*>(&w); } while (0)
  PK4(p0, 0, pa0); PK4(p0, 8, pa1); PK4(p1, 0, pa2); PK4(p1, 8, pa3);
#undef PK4
}
__device__ __forceinline__ void qkt(f32x16& p0, f32x16& p1, const bf16_t* Ks, const bf16x8* qr, int r32, int hi) {
  p0 = f32x16{}; p1 = f32x16{};
  for (int d0 = 0; d0 < 8; ++d0) { int cb = (d0 * 16 + hi * 8) * 2;
    bf16x8 b0 = *reinterpret_cast<const bf16x8*>((const char*)Ks + KSWZ(r32, cb));
    bf16x8 b1 = *reinterpret_cast<const bf16x8*>((const char*)Ks + KSWZ(32 + r32, cb));
    p0 = __builtin_amdgcn_mfma_f32_32x32x16_bf16(b0, qr[d0], p0, 0, 0, 0);
    p1 = __builtin_amdgcn_mfma_f32_32x32x16_bf16(b1, qr[d0], p1, 0, 0, 0); }
}
__device__ __forceinline__ int v_st(int k, int c) { const int kk = (k & ~0xC) | ((k & 4) << 1) | ((k & 8) >> 1); return ((kk >> 3) * 4 + (c >> 5)) * 512 + ((kk & 7) * 32 + (c & 31)) * 2; }
__device__ __forceinline__ int v_rd_base(int lane) { return ((lane & 3) << 3) | (((lane >> 2) & 3) << 6) | (((lane >> 4) & 1) << 5) | (((lane >> 5) & 1) << 8); }
constexpr int v_rd_off(int d0, int ks, int half) { return d0 * 512 + ks * 4096 + half * 2048; }
template <int OFF> __device__ __forceinline__ s16x4 tr_read(int vb) {
  s16x4 r; asm volatile("ds_read_b64_tr_b16 %0, %1 offset:%2" : "=&v"(r) : "v"(vb), "i"(OFF) : "memory"); return r;
}
template <int D0> __device__ __forceinline__ void pv_one(f32x16& od, int vb, bf16x8 pa0, bf16x8 pa1, bf16x8 pa2, bf16x8 pa3) {
  const s16x4 l0 = tr_read<v_rd_off(D0, 0, 0)>(vb), h0 = tr_read<v_rd_off(D0, 0, 1)>(vb), l1 = tr_read<v_rd_off(D0, 1, 0)>(vb), h1 = tr_read<v_rd_off(D0, 1, 1)>(vb);
  const s16x4 l2 = tr_read<v_rd_off(D0, 2, 0)>(vb), h2 = tr_read<v_rd_off(D0, 2, 1)>(vb), l3 = tr_read<v_rd_off(D0, 3, 0)>(vb), h3 = tr_read<v_rd_off(D0, 3, 1)>(vb);
  asm volatile("s_waitcnt lgkmcnt(0)" ::: "memory"); SBAR();
#define PK(L, H) (bf16x8){L[0], L[1], L[2], L[3], H[0], H[1], H[2], H[3]}
  od = __builtin_amdgcn_mfma_f32_32x32x16_bf16(pa0, PK(l0, h0), od, 0, 0, 0);
  od = __builtin_amdgcn_mfma_f32_32x32x16_bf16(pa1, PK(l1, h1), od, 0, 0, 0);
  od = __builtin_amdgcn_mfma_f32_32x32x16_bf16(pa2, PK(l2, h2), od, 0, 0, 0);
  od = __builtin_amdgcn_mfma_f32_32x32x16_bf16(pa3, PK(l3, h3), od, 0, 0, 0);
#undef PK
}
__device__ __forceinline__ void pv_d0(f32x16* o, int vb, bf16x8 pa0, bf16x8 pa1, bf16x8 pa2, bf16x8 pa3) {
  pv_one<0>(o[0], vb, pa0, pa1, pa2, pa3); pv_one<1>(o[1], vb, pa0, pa1, pa2, pa3); pv_one<2>(o[2], vb, pa0, pa1, pa2, pa3); pv_one<3>(o[3], vb, pa0, pa1, pa2, pa3);
}
__device__ __forceinline__ void attn_unit(const bf16_t* __restrict__ Qb, const bf16_t* __restrict__ Kh, const bf16_t* __restrict__ Vh,
                                          bf16_t* __restrict__ Ob, const float* __restrict__ gain, int seq, char* lds, int g_wave) {
  const int tid = opaque_tid(), wid = tid >> 6, lane = tid & 63, r32 = lane & 31, hi = lane >> 5;
  bf16_t* V_lds = (bf16_t*)lds; bf16_t* K_lds = (bf16_t*)(lds + 2 * SHM_V);
  float* ws = (float*)(lds + 2 * SHM_V + 2 * SHM_K) + wid * 64; float* li_l = ws; float* al_l = ws + 32;
  float m_reg = -1e30f, l_reg = 0; f32x16 o[4] = {}; bf16x8 qr[8];
  const bf16_t* Qw = Qb + (long)(wid * QBLK + r32) * LDQ + hi * 8;
#pragma unroll
  for (int d0 = 0; d0 < 8; ++d0) qr[d0] = *reinterpret_cast<const bf16x8*>(Qw + d0 * 16);
  const int sr = tid >> 4, sc = (tid & 15) * 8, vst0 = v_st(sr, sc), vst1 = v_st(32 + sr, sc);
  const int vb0 = (int)(uintptr_t)V_lds + v_rd_base(lane);
  struct { bf16x8 vs0, vs1, ks0, ks1; } sr_[2];
  const unsigned soff0 = (unsigned)(sr * LDKV + sc) * 2u, soff1 = soff0 + 32u * LDKV * 2u;
#define SLOAD(i, k0) do { const char* vb_ = (const char*)Vh + (size_t)(k0) * (LDKV * 2); const char* kb_ = (const char*)Kh + (size_t)(k0) * (LDKV * 2); \
    sr_[i].vs0 = *reinterpret_cast<const bf16x8*>(vb_ + soff0); sr_[i].vs1 = *reinterpret_cast<const bf16x8*>(vb_ + soff1); \
    sr_[i].ks0 = *reinterpret_cast<const bf16x8*>(kb_ + soff0); sr_[i].ks1 = *reinterpret_cast<const bf16x8*>(kb_ + soff1); } while (0)
#define SWRITE(b, i) do { *(bf16x8*)((char*)V_lds + (b) * SHM_V + vst0) = sr_[i].vs0;          \
    *(bf16x8*)((char*)V_lds + (b) * SHM_V + vst1) = sr_[i].vs1; int kc = sc * 2;               \
    *(bf16x8*)((char*)K_lds + (b) * SHM_K + KSWZ(sr, kc)) = sr_[i].ks0;                       \
    *(bf16x8*)((char*)K_lds + (b) * SHM_K + KSWZ(32 + sr, kc)) = sr_[i].ks1; } while (0)
#define SWAIT() asm volatile("s_waitcnt vmcnt(4)" ::: "memory")
#define RESC(a) do { if (__any((a) < 1.f)) { if (hi == 0) al_l[r32] = (a); asm volatile("s_waitcnt lgkmcnt(0)" ::: "memory"); \
    for (int d = 0; d < 4; ++d) for (int r = 0; r < 16; ++r) o[d][r] *= al_l[crow(r, hi)]; } } while (0)
  f32x16 pA0, pA1, pB0, pB1; float mnA, mnB, alA, alB; bf16x8 pa0, pa1, pa2, pa3; const int NT = seq / KVBLK;
  constexpr int SE = 0, SO = 1;
  SLOAD(SE, 0); SLOAD(SO, KVBLK); asm volatile("s_waitcnt vmcnt(4)" ::: "memory"); SWRITE(0, SE); __syncthreads();
  qkt(pA0, pA1, K_lds, qr, r32, hi); partialSM(pA0, pA1, m_reg, mnA, alA);
  if (2 < NT) SLOAD(SE, 2 * KVBLK);
  SWAIT(); SWRITE(1, SO); __syncthreads();
  for (int j = 1; j + 1 < NT; j += 2) {
    SBAR(); qkt(pB0, pB1, (bf16_t*)((char*)K_lds + SHM_K), qr, r32, hi);
    finishSM(pA0, pA1, alA, l_reg, pa0, pa1, pa2, pa3); SBAR();
    SLOAD(SO, (j + 2) * KVBLK); SBAR();
    pv_d0(o, vb0, pa0, pa1, pa2, pa3); partialSM(pB0, pB1, m_reg, mnB, alB);
    __syncthreads(); SWAIT(); SWRITE(0, SE);
    RESC(alB); __syncthreads();
    SBAR(); qkt(pA0, pA1, K_lds, qr, r32, hi);
    finishSM(pB0, pB1, alB, l_reg, pa0, pa1, pa2, pa3); SBAR();
    if (j + 3 < NT) SLOAD(SE, (j + 3) * KVBLK); SBAR();
    pv_d0(o, vb0 + (int)SHM_V, pa0, pa1, pa2, pa3); partialSM(pA0, pA1, m_reg, mnA, alA);
    __syncthreads(); SWAIT(); SWRITE(1, SO);
    RESC(alA); __syncthreads();
  }
  SBAR(); qkt(pB0, pB1, (bf16_t*)((char*)K_lds + SHM_K), qr, r32, hi);
  finishSM(pA0, pA1, alA, l_reg, pa0, pa1, pa2, pa3); SBAR();
  pv_d0(o, vb0, pa0, pa1, pa2, pa3); partialSM(pB0, pB1, m_reg, mnB, alB);
  __syncthreads(); RESC(alB);
  finishSM(pB0, pB1, alB, l_reg, pa0, pa1, pa2, pa3); SBAR();
  pv_d0(o, vb0 + (int)SHM_V, pa0, pa1, pa2, pa3);
  if (hi == 0) li_l[r32] = l_reg; asm volatile("s_waitcnt lgkmcnt(0)" ::: "memory");
  float gn[4];
#pragma unroll
  for (int d0 = 0; d0 < 4; ++d0) gn[d0] = gain[d0 * 32 + r32];
  char* Ow = (char*)Ob + (size_t)(wid * QBLK) * (LDO * 2);
  const unsigned ooff = (unsigned)(4 * hi * LDO + r32) * 2u;
#pragma unroll
  for (int r = 0; r < 16; ++r) { const int orow = crow(r, hi); const float rli = __builtin_amdgcn_rcpf(li_l[orow]);
    float v0 = o[0][r] * rli, v1 = o[1][r] * rli, v2 = o[2][r] * rli, v3 = o[3][r] * rli;
    float ss = v0 * v0 + v1 * v1 + v2 * v2 + v3 * v3;
    ss = half_sum(ss);
    const float rs = rsqrtf(ss * (1.0f / 128.0f) + EPS);
    const unsigned w01 = cvt_pk_bf16(v0 * rs * gn[0], v1 * rs * gn[1]), w23 = cvt_pk_bf16(v2 * rs * gn[2], v3 * rs * gn[3]);
    char* op = Ow + (size_t)((r & 3) + 8 * (r >> 2)) * (LDO * 2);
    *(bf16_t*)(op + ooff) = (bf16_t)(w01 & 0xffffu); *(bf16_t*)(op + ooff + 64) = (bf16_t)(w01 >> 16);
    *(bf16_t*)(op + ooff + 128) = (bf16_t)(w23 & 0xffffu); *(bf16_t*)(op + ooff + 192) = (bf16_t)(w23 >> 16); }
#undef SLOAD
#undef SWRITE
#undef SWAIT
#undef RESC
}
}

#define XB_TMO      128
#define XB_XCNT(j)  (256  + 64 * (j))
#define XB_XSUB(j)  (1280 + 64 * (j))
#define XB_XGEN(j)  (2304 + 64 * (j))
#define XB_TOP      3328
#define XB_TOPGEN   3392
#define XCD_BAR_WORDS 3456
#define XB_SPIN_CAP (1u << 18)
__device__ __forceinline__ unsigned xb_ld(unsigned* p)              { return __hip_atomic_load(p, __ATOMIC_RELAXED, __HIP_MEMORY_SCOPE_AGENT); }
__device__ __forceinline__ unsigned xb_add(unsigned* p, unsigned v) { return __hip_atomic_fetch_add(p, v, __ATOMIC_RELAXED, __HIP_MEMORY_SCOPE_AGENT); }
__device__ __forceinline__ unsigned xb_xcc_id() { return (unsigned)__builtin_amdgcn_s_getreg((3 << 11) | 20) & 0xFu; }
#define XB_SPIN(cond, bar) do { unsigned _sp = 0; while (cond) { __builtin_amdgcn_s_sleep(1); \
    if ((++_sp & 255u) == 0u) { if (xb_ld(&(bar)[XB_TMO])) break; if (_sp > XB_SPIN_CAP) { atomicAdd(&(bar)[XB_TMO], 1u); break; } } } } while (0)
struct XcdBarrier { unsigned* bar; unsigned x; volatile LAS unsigned* st; };
__device__ __forceinline__ XcdBarrier xcd_barrier_post(unsigned* bar, volatile LAS unsigned* st, int g_wave) {
    XcdBarrier b; b.bar = bar; b.x = xb_xcc_id(); b.st = st;
    if (MY_TID() == 0) (void)xb_add(&bar[XB_XCNT(b.x)], 1u);
    return b;
}
__device__ __forceinline__ void xcd_barrier_complete(unsigned* bar, unsigned x, unsigned& nloc, unsigned& nx) {
    const unsigned G = gridDim.x * gridDim.y * gridDim.z;
    unsigned sum, cnt, mine, sp = 0u;
    for (;;) {
        sum = 0u; cnt = 0u; mine = 0u;
#pragma unroll
        for (unsigned j = 0; j < 16; ++j) { const unsigned c = xb_ld(&bar[XB_XCNT(j)]); sum += c; cnt += (c > 0u) ? 1u : 0u; mine = (j == x) ? c : mine; }
        if (sum == G) break;
        __builtin_amdgcn_s_sleep(1);
        if ((++sp & 255u) == 0u) { if (xb_ld(&bar[XB_TMO])) break; if (sp > XB_SPIN_CAP) { atomicAdd(&bar[XB_TMO], 1u); break; } }
    }
    nloc = mine > 0u ? mine : 1u; nx = cnt > 0u ? cnt : 1u;
}
__device__ __forceinline__ void xcd_barrier(const XcdBarrier& b, int g_wave) {
    asm volatile("s_waitcnt vmcnt(0)" ::: "memory");
    __syncthreads();
    if (MY_TID() == 0) {
        unsigned* bar = b.bar;
        __builtin_amdgcn_s_waitcnt(0);
        unsigned nloc = b.st[0], nx = b.st[1];
        if (nloc == 0u) { xcd_barrier_complete(bar, b.x, nloc, nx); b.st[0] = nloc; b.st[1] = nx; }
        const unsigned old = xb_add(&bar[XB_XSUB(b.x)], 1u);
        const unsigned gen = old / nloc;
        if (old + 1u == (gen + 1u) * nloc) {
            __builtin_amdgcn_fence(__ATOMIC_RELEASE, "agent");
            asm volatile("s_waitcnt vmcnt(0)" ::: "memory");
            const unsigned og = xb_add(&bar[XB_TOP], 1u);
            const unsigned tg = og / nx;
            if (og + 1u == (tg + 1u) * nx) xb_add(&bar[XB_TOPGEN], 1u);
            else XB_SPIN(xb_ld(&bar[XB_TOPGEN]) == tg, bar);
            __builtin_amdgcn_fence(__ATOMIC_ACQUIRE, "agent");
            xb_add(&bar[XB_XGEN(b.x)], 1u);
            asm volatile("s_waitcnt vmcnt(0)" ::: "memory");
        } else {
            XB_SPIN(xb_ld(&bar[XB_XGEN(b.x)]) == gen, bar);
            __builtin_amdgcn_fence(__ATOMIC_ACQUIRE, "agent");
            asm volatile("s_waitcnt vmcnt(0)" ::: "memory");
        }
    }
    __syncthreads();
}

struct Args { const float* in[20]; float* out; unsigned char* ws; int ph_lo, ph_hi; };
typedef const Args __attribute__((address_space(4)))* KArgP;
__device__ __forceinline__ KArgP kargs() { KArgP p = (KArgP)__builtin_amdgcn_kernarg_segment_ptr(); asm volatile("" : "+s"(p)); return p; }
enum { I_X = 0, I_C, I_N1G, I_WADA, I_BADA, I_WIN, I_QNG, I_KNG, I_CONVW, I_AOG, I_COG, I_WOUT, I_N2G, I_DWG, I_DWU, I_DWD, I_ROUTER, I_MWG, I_MWU, I_MWD };

__device__ __forceinline__ void gemv_item(const float* wada, float* modp, const LAS float* cact, int it, int lane) {
    const int kc = it & 7, cg = (it >> 3) % 192, l = it / (8 * 192);
    const int n = cg * 64 + lane;
    const float* w = wada + ((size_t)l * DM + kc * 256) * MODW + n;
    float acc[8];
#pragma unroll
    for (int b = 0; b < 8; ++b) acc[b] = 0.f;
#pragma nounroll
    for (int k0 = 0; k0 < 256; k0 += 16) {
        float wv[16];
#pragma unroll
        for (int j = 0; j < 16; ++j) wv[j] = w[(size_t)(k0 + j) * MODW];
#pragma unroll
        for (int j4 = 0; j4 < 16; j4 += 4) {
#pragma unroll
            for (int b = 0; b < 8; ++b) { const f32x4 cv = *(const LAS f32x4*)(cact + b * DM + kc * 256 + k0 + j4);
                acc[b] += cv.x * wv[j4] + cv.y * wv[j4 + 1] + cv.z * wv[j4 + 2] + cv.w * wv[j4 + 3]; }
        }
    }
#pragma unroll
    for (int b = 0; b < 8; ++b) modp[((size_t)(l * 8 + kc) * 8 + b) * MODW + n] = acc[b];
}
constexpr int J_WIN = 16 * 72, J_WOUT = 16 * 32, J_DG = 16 * 88, J_DD = 44 * 32, J_MG = 16 * 64, J_MD = 32 * 32;
constexpr int CV_WIN0 = 0, CV_WOUT0 = CV_WIN0 + J_WIN, CV_DG = CV_WOUT0 + J_WOUT, CV_DD = CV_DG + 2 * J_DG, CV_WIN1 = CV_DD + J_DD, CV_WOUT1 = CV_WIN1 + J_WIN, CV_MG = CV_WOUT1 + J_WOUT, CV_MD = CV_MG + 16 * J_MG, CV_END = CV_MD + 8 * J_MD;
struct CvDesc { const float* W; unsigned char* WT; int K, N, n0, k0, drow0; bool f8; bool nostore; };
__device__ __forceinline__ CvDesc cv_decode(KArgP a, int it, int half) {
    int r = it; CvDesc d; int mode = 0; d.f8 = false; d.nostore = false;
    int winl = -1;
    if (r < CV_WOUT0) { d.W = a->in[I_WIN]; d.K = DM; d.N = IN_W; d.WT = a->ws + WS_WIN; winl = 0; }
    else if (r < CV_DG) { r -= CV_WOUT0; d.W = a->in[I_WOUT]; d.K = DM; d.N = DM; d.WT = a->ws + WS_WOUT; }
    else if (r < CV_DD) { r -= CV_DG; const int u = r / J_DG; r -= u * J_DG; d.W = a->in[u ? I_DWU : I_DWG]; d.K = DM; d.N = FFD; mode = 1 + u; d.WT = a->ws + WS_DGU; d.f8 = MK_FP8_DUP != 0; }
    else if (r < CV_WIN1) { r -= CV_DD; d.W = a->in[I_DWD]; d.K = FFD; d.N = DM; d.WT = a->ws + WS_DDN; d.f8 = MK_FP8_DDN != 0; }
    else if (r < CV_WOUT1) { r -= CV_WIN1; d.W = a->in[I_WIN] + (size_t)DM * IN_W; d.K = DM; d.N = IN_W; d.WT = a->ws + WS_WIN + (size_t)IN_W * DM * 2; winl = 1; }
    else if (r < CV_MG) { r -= CV_WOUT1; d.W = a->in[I_WOUT] + (size_t)DM * DM; d.K = DM; d.N = DM; d.WT = a->ws + WS_WOUT + (size_t)DM * DM * 2; }
    else if (r < CV_MD) { r -= CV_MG; const int q = r / J_MG; r -= q * J_MG; const int e = q >> 1, u = q & 1; d.W = a->in[u ? I_MWU : I_MWG] + (size_t)e * DM * FFE; d.K = DM; d.N = FFE; mode = 1 + u; d.f8 = MK_FP8_MOE != 0;
        d.WT = a->ws + WS_MGU + (size_t)e * 2 * FFE * DM * (MK_FP8_MOE ? 1 : 2); }
    else { r -= CV_MD; const int e = r / J_MD; r -= e * J_MD; d.W = a->in[I_MWD] + (size_t)e * FFE * DM; d.K = FFE; d.N = DM; d.f8 = MK_FP8_MOE != 0; d.WT = a->ws + WS_MDN + (size_t)e * DM * FFE * (MK_FP8_MOE ? 1 : 2); }
    const int nblk = d.N >> 6, kb2 = r / nblk, nb = r - kb2 * nblk;
    d.n0 = nb << 6; d.k0 = (kb2 * 2 + half) << 6;
    if (MK_FP8_QKV && winl >= 0 && d.n0 < QKV_W) { d.f8 = true; d.WT = a->ws + WS_WIN8 + (size_t)winl * QKV_W * DM; }
    d.drow0 = mode ? ((d.n0 >> 7) << 8) + (d.n0 & 127) + (mode == 2 ? 128 : 0) : d.n0;
    if (MK_UFUSE && winl >= 0) {
        if (d.n0 >= OFF_GC) { const int ch = d.n0 - OFF_GC; d.drow0 = OFF_HC + ((ch >> 7) << 8) + 128 + (ch & 127); }
        else if (d.n0 >= OFF_GB) d.drow0 = d.n0 + 1024;
        else if (d.n0 >= OFF_HC) { const int ch = d.n0 - OFF_HC; d.drow0 = OFF_HC + ((ch >> 7) << 8) + (ch & 127); } }
    return d;
}
__device__ __forceinline__ void cv_load(const CvDesc& d, f32x4 (&v)[16], int lane) {
    if (d.f8) {
        const float* src = d.W + (size_t)(d.k0 + 4 * (lane >> 4)) * d.N + d.n0 + (lane & 15) * 4;
#pragma unroll
        for (int i = 0; i < 4; ++i)
#pragma unroll
            for (int r = 0; r < 4; ++r) v[4 * i + r] = __builtin_nontemporal_load((const f32x4*)(src + (size_t)(16 * i + r) * d.N));
    } else {
        const float* src = d.W + (size_t)(d.k0 + (lane >> 4)) * d.N + d.n0 + (lane & 15) * 4;
#pragma unroll
        for (int i = 0; i < 16; ++i) v[i] = __builtin_nontemporal_load((const f32x4*)(src + (size_t)(4 * i) * d.N));
    }
}
__device__ __forceinline__ void cv_process(const CvDesc& d, const f32x4 (&v)[16], LAS float* scr, int lane) {
    if (d.f8) {
        LAS unsigned* T = (LAS unsigned*)scr; const int kq = lane >> 4, c4 = lane & 15;
#pragma unroll
        for (int i = 0; i < 4; ++i) { LAS unsigned* p = T + (4 * c4) * 17 + 4 * i + kq;
            p[0 * 17] = pk4_fp8(v[4 * i][0] * FP8_WSCALE, v[4 * i + 1][0] * FP8_WSCALE, v[4 * i + 2][0] * FP8_WSCALE, v[4 * i + 3][0] * FP8_WSCALE);
            p[1 * 17] = pk4_fp8(v[4 * i][1] * FP8_WSCALE, v[4 * i + 1][1] * FP8_WSCALE, v[4 * i + 2][1] * FP8_WSCALE, v[4 * i + 3][1] * FP8_WSCALE);
            p[2 * 17] = pk4_fp8(v[4 * i][2] * FP8_WSCALE, v[4 * i + 1][2] * FP8_WSCALE, v[4 * i + 2][2] * FP8_WSCALE, v[4 * i + 3][2] * FP8_WSCALE);
            p[3 * 17] = pk4_fp8(v[4 * i][3] * FP8_WSCALE, v[4 * i + 1][3] * FP8_WSCALE, v[4 * i + 2][3] * FP8_WSCALE, v[4 * i + 3][3] * FP8_WSCALE); }
        LDS_WAIT(); asm volatile("" ::: "memory");
        const int q4 = lane & 3;
#pragma unroll
        for (int j = 0; j < 4; ++j) { const int n = (lane >> 2) + 16 * j; const LAS unsigned* sp = T + n * 17 + 4 * q4;
            u32x4 o; o.x = sp[0]; o.y = sp[1]; o.z = sp[2]; o.w = sp[3];
            if (d.nostore) asm volatile("" :: "v"(o)); else __builtin_nontemporal_store(o, (u32x4*)(d.WT + (size_t)(d.drow0 + n) * d.K + d.k0 + 16 * q4)); }
        LDS_WAIT(); asm volatile("" ::: "memory");
        return;
    }
#pragma unroll
    for (int i = 0; i < 16; ++i) { LAS float* p = scr + (4 * i + (lane >> 4)) * 65 + (lane & 15) * 4; p[0] = v[i].x; p[1] = v[i].y; p[2] = v[i].z; p[3] = v[i].w; }
    LDS_WAIT(); asm volatile("" ::: "memory");
    { const int c = lane & 7;
#pragma unroll
        for (int j = 0; j < 8; ++j) { const int n = (lane >> 3) + 8 * j; const LAS float* sp = scr + (8 * c) * 65 + n;
            u32x4 o; o.x = cvt_pk_bf16(sp[0 * 65], sp[1 * 65]); o.y = cvt_pk_bf16(sp[2 * 65], sp[3 * 65]); o.z = cvt_pk_bf16(sp[4 * 65], sp[5 * 65]); o.w = cvt_pk_bf16(sp[6 * 65], sp[7 * 65]);
            __builtin_nontemporal_store(o, (u32x4*)((bf16_t*)d.WT + (size_t)(d.drow0 + n) * d.K + d.k0 + 8 * c)); }
    }
    LDS_WAIT(); asm volatile("" ::: "memory");
}
__device__ __forceinline__ void convert_items(KArgP a, LAS unsigned char* lds, int wg, int nwg, int g_wave, int first, int last, bool nostore = false) {
    const int tid = opaque_tid(), lane = tid & 63, wave = __builtin_amdgcn_readfirstlane(tid >> 6);
    const int gw = wg * 8 + wave, NGW = nwg * 8;
    LAS float* scr = (LAS float*)(lds + wave * 16640);
    const int it0 = first + (NGW - 1 - gw);
    if (it0 >= last) return;
    const int nsub = 2 * ((last - 1 - it0) / NGW + 1);
    f32x4 vA[16], vB[16], vC[16];
    CvDesc dA, dB, dC;
#define CV_ISSUE(D, V, q) do { D = cv_decode(a, it0 + ((q) >> 1) * NGW, (q) & 1); D.nostore = nostore; cv_load(D, V, lane); } while (0)
    CV_ISSUE(dA, vA, 0);
    if (1 < nsub) CV_ISSUE(dB, vB, 1);
    for (int q = 0; q < nsub; q += 3) {
        if (q + 2 < nsub) CV_ISSUE(dC, vC, q + 2);
        __builtin_amdgcn_sched_barrier(0);
        cv_process(dA, vA, scr, lane);
        __builtin_amdgcn_sched_barrier(0);
        if (q + 1 >= nsub) break;
        if (q + 3 < nsub) CV_ISSUE(dA, vA, q + 3);
        __builtin_amdgcn_sched_barrier(0);
        cv_process(dB, vB, scr, lane);
        __builtin_amdgcn_sched_barrier(0);
        if (q + 2 >= nsub) break;
        if (q + 4 < nsub) CV_ISSUE(dB, vB, q + 4);
        __builtin_amdgcn_sched_barrier(0);
        cv_process(dC, vC, scr, lane);
        __builtin_amdgcn_sched_barrier(0);
    }
#undef CV_ISSUE
}
__device__ __forceinline__ void cv_probe_loads(KArgP a, int G, int g_wave, int shape) {
    const int tid = opaque_tid(), lane = tid & 63, wave = __builtin_amdgcn_readfirstlane(tid >> 6);
    const int gw = blockIdx.x * 8 + wave, NGW = G * 8;
    for (int it = (NGW - 1 - gw); it < 16 * 1024; it += NGW) {
        const int q = it >> 10, r = it & 1023, e = q >> 1, u = q & 1;
        const float* W = a->in[u ? I_MWU : I_MWG] + (size_t)e * DM * FFE;
        const float* src; size_t step;
        if (shape == 0 || shape >= 10) { const int kb = r >> 6, nb = r & 63; src = W + (size_t)(kb * 128 + (lane >> 4)) * FFE + nb * 64 + (lane & 15) * 4; step = (size_t)4 * FFE; }
        else if (shape == 1) { const int kb = r >> 5, nb = r & 31; src = W + (size_t)(kb * 64 + (lane >> 5)) * FFE + nb * 128 + (lane & 31) * 4; step = (size_t)2 * FFE; }
        else if (shape == 3) { src = W + (size_t)r * 8192 + lane * 4; step = 256; }
        else { const int kb = r >> 4, nb = r & 15; src = W + (size_t)(kb * 32) * FFE + nb * 256 + lane * 4; step = (size_t)FFE; }
        const int depth = shape == 10 ? 8 : (shape == 11 ? 16 : 32);
        for (int i0 = 0; i0 < 32; i0 += depth) {
            f32x4 v[32];
            if (depth == 8) {
#pragma unroll
                for (int i = 0; i < 8; ++i) v[i] = __builtin_nontemporal_load((const f32x4*)(src + (i0 + i) * step));
#pragma unroll
                for (int i = 0; i < 8; ++i) asm volatile("" :: "v"(v[i]));
            } else if (depth == 16) {
#pragma unroll
                for (int i = 0; i < 16; ++i) v[i] = __builtin_nontemporal_load((const f32x4*)(src + (i0 + i) * step));
#pragma unroll
                for (int i = 0; i < 16; ++i) asm volatile("" :: "v"(v[i]));
            } else {
#pragma unroll
                for (int i = 0; i < 32; ++i) v[i] = __builtin_nontemporal_load((const f32x4*)(src + i * step));
#pragma unroll
                for (int i = 0; i < 32; ++i) asm volatile("" :: "v"(v[i]));
            }
        }
    }
}
__device__ __forceinline__ void p0_prologue(KArgP a, LAS unsigned char* lds, int G, int g_wave, int skip  ) {
    const int tid = opaque_tid(), lane = tid & 63, wave = __builtin_amdgcn_readfirstlane(tid >> 6);
    const int gw = blockIdx.x * 8 + wave, NGW = G * 8;
    LAS float* cact = (LAS float*)lds;
    {
        const float* cin = a->in[I_C];
#pragma nounroll
        for (int i0 = 0; i0 < BATCH * DM; i0 += 16 * 512) { float cv[16];
#pragma unroll
            for (int k = 0; k < 16; ++k) cv[k] = cin[i0 + k * 512 + tid];
#pragma unroll
            for (int k = 0; k < 16; ++k) cact[i0 + k * 512 + tid] = cv[k] / (1.0f + __expf(-cv[k])); } }
    __syncthreads();
    float* modp = (float*)(a->ws + WS_MODP);
    if (skip != 1 && skip < 3) for (int it = gw; it < 2 * 192 * 8; it += NGW) gemv_item(a->in[I_WADA], modp, cact, it, lane);
    __syncthreads();
    if (skip >= 7) cv_probe_loads(a, G, g_wave, skip - 7);
    else if (skip >= 3) { if (skip != 6 || blockIdx.x < 32) convert_items(a, lds, (int)blockIdx.x, skip == 6 ? 32 : G, g_wave, CV_MG, skip == 6 ? CV_MG + (CV_END - CV_MG) / 8 : CV_END, skip == 4); }
    else if (skip != 2) convert_items(a, lds, (int)blockIdx.x, G, g_wave, CV_WIN0, (MK_CVSPLIT && G == 256) ? CV_WOUT0 + (int)((long)(CV_END - CV_WOUT0) * MK_CVP0 / 100) : CV_END);
}

template <bool FROM_PARTIALS, bool ROUTER, int OUT8 = 0  , bool XIN_BF = false  >
__device__ __forceinline__ void norm_pass(KArgP a, int l, int which  , const void* xin_, LAS unsigned char* lds, int G, int g_wave) {
    const int tid = opaque_tid(), lane = tid & 63, wave = __builtin_amdgcn_readfirstlane(tid >> 6);
    LAS float* Amul = (LAS float*)lds; LAS float* Badd = Amul + DM; LAS float* rT = Badd + DM;
    const float* gn = a->in[which ? I_N2G : I_N1G] + (size_t)l * DM;
    const float* modp = (const float*)(a->ws + WS_MODP); float* modf = (float*)(a->ws + WS_MODF);
    const float* bada = a->in[I_BADA];
    bf16_t* H = (bf16_t*)(a->ws + WS_H); unsigned char* H8 = a->ws + WS_H8;
    if (FROM_PARTIALS) {
        for (int idx = blockIdx.x * 512 + tid; idx < 2 * 8 * MODW; idx += G * 512) { const int n = idx % MODW, lb = idx / MODW, ll = lb >> 3, b = lb & 7;
            float s = bada[(size_t)ll * MODW + n];
#pragma unroll
            for (int kc = 0; kc < 8; ++kc) s += modp[((size_t)(ll * 8 + kc) * 8 + b) * MODW + n];
            modf[idx] = s; }
    }
    if (ROUTER) { const float* rw = a->in[I_ROUTER];
#pragma nounroll
        for (int i0 = 0; i0 < DM * NEXP; i0 += 16 * 512) { float rv[16];
#pragma unroll
            for (int k = 0; k < 16; ++k) rv[k] = rw[i0 + k * 512 + tid];
#pragma unroll
            for (int k = 0; k < 16; ++k) { const int i = i0 + k * 512 + tid; rT[(i & 7) * DM + (i >> 3)] = rv[k]; } } }
    int* sel = (int*)(a->ws + WS_ROUTE + RT_SEL); f32x2* wts = (f32x2*)(a->ws + WS_ROUTE + RT_WTS);
    for (int chunk0 = blockIdx.x; chunk0 < M / 64; chunk0 += G) { const int chunk = (G == 256) ? ((chunk0 & 7) << 5) + (chunk0 >> 3) : chunk0;
        const int b = chunk >> 5;
        __syncthreads();
#pragma unroll
        for (int col = tid; col < DM; col += 512) { float sh, sc;
            const int ish = (which ? 3 : 0) * DM + col, isc = ish + DM;
            if (FROM_PARTIALS) { sh = bada[(size_t)l * MODW + ish]; sc = bada[(size_t)l * MODW + isc];
#pragma unroll
                for (int kc = 0; kc < 8; ++kc) { sh += modp[((size_t)(l * 8 + kc) * 8 + b) * MODW + ish]; sc += modp[((size_t)(l * 8 + kc) * 8 + b) * MODW + isc]; } }
            else { sh = modf[(size_t)(l * 8 + b) * MODW + ish]; sc = modf[(size_t)(l * 8 + b) * MODW + isc]; }
            Amul[col] = gn[col] * (1.0f + sc); Badd[col] = sh; }
        __syncthreads();
        u32x4 cw[4]; f32x4 cf[4][2];
#define NORM_LOAD(W, F, row_) do { _Pragma("unroll") for (int j = 0; j < 4; ++j) { \
            if (XIN_BF) W[j] = *(const u32x4*)((const bf16_t*)xin_ + (size_t)(row_) * DM + 8 * lane + 512 * j); \
            else { const float* xr = (const float*)xin_ + (size_t)(row_) * DM + 8 * lane; F[j][0] = *(const f32x4*)(xr + 512 * j); F[j][1] = *(const f32x4*)(xr + 512 * j + 4); } } } while (0)
        NORM_LOAD(cw, cf, chunk * 64 + wave * 8);
#pragma nounroll
        for (int i = 0; i < 8; ++i) { const int row = chunk * 64 + wave * 8 + i;
            u32x4 nw[4]; f32x4 nf[4][2];
#pragma unroll
            for (int j = 0; j < 4; ++j) { nw[j] = cw[j]; nf[j][0] = cf[j][0]; nf[j][1] = cf[j][1]; }
            if (i + 1 < 8) NORM_LOAD(nw, nf, row + 1);
            f32x4 v[4][2]; float ss = 0.f;
#pragma unroll
            for (int j = 0; j < 4; ++j) {
                if (XIN_BF) { const u32x4 w = cw[j];
                    v[j][0] = (f32x4){bf_lo(w.x), bf_hi(w.x), bf_lo(w.y), bf_hi(w.y)}; v[j][1] = (f32x4){bf_lo(w.z), bf_hi(w.z), bf_lo(w.w), bf_hi(w.w)}; }
                else { v[j][0] = cf[j][0]; v[j][1] = cf[j][1]; }
                ss += (v[j][0].x * v[j][0].x + v[j][0].y * v[j][0].y) + (v[j][0].z * v[j][0].z + v[j][0].w * v[j][0].w) + (v[j][1].x * v[j][1].x + v[j][1].y * v[j][1].y) + (v[j][1].z * v[j][1].z + v[j][1].w * v[j][1].w); }
            ss = wave_sum(ss);
            const float rstd = rsqrtf(ss * (1.0f / DM) + EPS);
            float lg[8];
#pragma unroll
            for (int e = 0; e < 8; ++e) lg[e] = 0.f;
#pragma unroll
            for (int j = 0; j < 4; ++j) { const int col = 8 * lane + 512 * j;
                const f32x4 a0 = *(const LAS f32x4*)(Amul + col), a1 = *(const LAS f32x4*)(Amul + col + 4), b0 = *(const LAS f32x4*)(Badd + col), b1 = *(const LAS f32x4*)(Badd + col + 4);
                const f32x4 h0 = v[j][0] * rstd * a0 + b0, h1 = v[j][1] * rstd * a1 + b1;
                if (OUT8 >= 1) { u32x2 w; w.x = pk4_fp8(h0.x * FP8_ASCALE, h0.y * FP8_ASCALE, h0.z * FP8_ASCALE, h0.w * FP8_ASCALE); w.y = pk4_fp8(h1.x * FP8_ASCALE, h1.y * FP8_ASCALE, h1.z * FP8_ASCALE, h1.w * FP8_ASCALE);
                    *(u32x2*)((OUT8 == 2 ? H8 : (unsigned char*)H) + (size_t)row * DM + col) = w; }
                if (OUT8 != 1) { u32x4 w; w.x = cvt_pk_bf16(h0.x, h0.y); w.y = cvt_pk_bf16(h0.z, h0.w); w.z = cvt_pk_bf16(h1.x, h1.y); w.w = cvt_pk_bf16(h1.z, h1.w);
                    *(u32x4*)(H + (size_t)row * DM + col) = w; }
                if (ROUTER) {
#pragma unroll
                    for (int e = 0; e < 8; ++e) { const f32x4 r0 = *(const LAS f32x4*)(rT + e * DM + col), r1 = *(const LAS f32x4*)(rT + e * DM + col + 4);
                        lg[e] += (h0.x * r0.x + h0.y * r0.y) + (h0.z * r0.z + h0.w * r0.w) + (h1.x * r1.x + h1.y * r1.y) + (h1.z * r1.z + h1.w * r1.w); }
                    asm volatile("" ::: "memory"); } }
            if (ROUTER) {
#pragma unroll
                for (int e = 0; e < 8; ++e) lg[e] = wave_sum(lg[e]);
                float m0 = lg[0]; int e0 = 0;
#pragma unroll
                for (int e = 1; e < 8; ++e) if (lg[e] > m0) { m0 = lg[e]; e0 = e; }
                float m1 = -3.0e38f; int e1 = 0;
#pragma unroll
                for (int e = 0; e < 8; ++e) if (e != e0 && lg[e] > m1) { m1 = lg[e]; e1 = e; }
                const float w0 = 1.0f / (1.0f + __expf(m1 - m0));
                if (lane == 0) { sel[row] = e0 | (e1 << 8); wts[row] = (f32x2){w0, 1.0f - w0}; }
            }
#pragma unroll
            for (int j = 0; j < 4; ++j) { cw[j] = nw[j]; cf[j][0] = nf[j][0]; cf[j][1] = nf[j][1]; }
        }
#undef NORM_LOAD
    }
}

__device__ __forceinline__ void route_pass(KArgP a, LAS unsigned char* lds, int G, int g_wave) {
    const int tid = opaque_tid(), lane = tid & 63, wave = __builtin_amdgcn_readfirstlane(tid >> 6);
    const int* sel = (const int*)(a->ws + WS_ROUTE + RT_SEL); int* posof = (int*)(a->ws + WS_ROUTE + RT_POSOF); int* rowlist = (int*)(a->ws + WS_ROUTE + RT_ROWLIST); int* tso = (int*)(a->ws + WS_ROUTE + RT_TS);
    LAS int* sh = (LAS int*)lds;
    int tot[8], bef1[8];
    const bool one = (G == M / 64);
    const int lim1 = one ? (int)blockIdx.x * 64 : 0;
#pragma unroll
    for (int e = 0; e < 8; ++e) { tot[e] = 0; bef1[e] = 0; }
#pragma nounroll
    for (int it = 0; it < M / 512; it += 16) { int sv[16];
#pragma unroll
        for (int k = 0; k < 16; ++k) sv[k] = sel[(it + k) * 512 + wave * 64 + lane];
#pragma unroll
        for (int k = 0; k < 16; ++k) { const int e0 = sv[k] & 255, e1 = sv[k] >> 8; const bool isbef = ((it + k) * 512 + wave * 64) < lim1;
#pragma unroll
            for (int e = 0; e < 8; ++e) { const int c = __popcll(__ballot(e0 == e)) + __popcll(__ballot(e1 == e)); tot[e] += c; bef1[e] += isbef ? c : 0; } } }
    __syncthreads();
    if (lane == 0) {
#pragma unroll
        for (int e = 0; e < 8; ++e) { sh[wave * 8 + e] = tot[e]; sh[128 + wave * 8 + e] = bef1[e]; } }
    __syncthreads();
    int T[8], ts[9]; ts[0] = 0;
#pragma unroll
    for (int e = 0; e < 8; ++e) { int s = 0;
#pragma unroll
        for (int w = 0; w < 8; ++w) s += sh[w * 8 + e];
        T[e] = s; ts[e + 1] = ts[e] + ((s + 255) >> 8); }
    for (int chunk = blockIdx.x; chunk < M / 64; chunk += G) {
        if (!one) {
        int bef[8];
#pragma unroll
        for (int e = 0; e < 8; ++e) bef[e] = 0;
        for (int base = wave * 64; base < chunk * 64; base += 512) { const int s = sel[base + lane]; const int e0 = s & 255, e1 = s >> 8;
#pragma unroll
            for (int e = 0; e < 8; ++e) bef[e] += __popcll(__ballot(e0 == e)) + __popcll(__ballot(e1 == e)); }
        __syncthreads();
        if (lane == 0) {
#pragma unroll
            for (int e = 0; e < 8; ++e) sh[64 + wave * 8 + e] = bef[e]; }
        __syncthreads(); }
        if (wave == 0) {
            const int row = chunk * 64 + lane; const int s = sel[row]; const int e0 = s & 255, e1 = s >> 8;
            const unsigned long long lt = (1ull << lane) - 1ull;
            int p0 = 0, p1 = 0;
#pragma unroll
            for (int e = 0; e < 8; ++e) { int B = 0;
#pragma unroll
                for (int w = 0; w < 8; ++w) B += sh[(one ? 128 : 64) + w * 8 + e];
                const unsigned long long m0 = __ballot(e0 == e), m1 = __ballot(e1 == e); const int basee = ts[e] * 256 + B;
                if (e0 == e) p0 = basee + __popcll(m0 & lt);
                if (e1 == e) p1 = basee + __popcll(m0) + __popcll(m1 & lt); }
            rowlist[p0] = row; rowlist[p1] = row; posof[row * 2] = p0; posof[row * 2 + 1] = p1;
        }
    }
    if (blockIdx.x < 8 && wave == 1) {
        int start = 0, end = 0;
#pragma unroll
        for (int e = 0; e < 8; ++e) if (e == (int)blockIdx.x) { start = ts[e] * 256 + T[e]; end = ts[e + 1] * 256; }
        for (int i = start + lane; i < end; i += 64) rowlist[i] = 0;
    }
    if (blockIdx.x == 0 && tid == 0) {
#pragma unroll
        for (int e = 0; e < 9; ++e) tso[e] = ts[e]; }
}

__device__ __forceinline__ void prep_pass(KArgP a, int l, LAS unsigned char* lds, int G, int g_wave) {
    const int tid = opaque_tid(), lane = tid & 63, wave = __builtin_amdgcn_readfirstlane(tid >> 6);
    LAS f32x2* tab = (LAS f32x2*)lds;
    for (int i = tid; i < 64 * 32; i += 512) { const int pos = i >> 5, fi = i & 31;
        const float inv = exp2f(-(float)fi * (13.287712379549449f / 32.0f));
        const float ang = (float)pos * inv; tab[i] = (f32x2){__cosf(ang), __sinf(ang)}; }
    __syncthreads();
    const bf16_t* P = (const bf16_t*)(a->ws + WS_P); bf16_t* MIX = (bf16_t*)(a->ws + WS_MIX); bf16_t* Qo = (bf16_t*)(a->ws + WS_Q); bf16_t* KVo = (bf16_t*)(a->ws + WS_KV);
    const float* qg = a->in[I_QNG] + l * HD; const float* kg = a->in[I_KNG] + l * HD;
    const float* cw = a->in[I_CONVW] + (size_t)l * 3 * 1024; const float* cog = a->in[I_COG] + (size_t)l * 1024;
    const int sq = (lane >> 2) & 1, cq = lane & 3;
    float gqa[8], gqb[8], gka[8], gkb[8];
#pragma unroll
    for (int j = 0; j < 8; ++j) { const int d = sq * 64 + 8 * cq + j; gqa[j] = qg[d]; gqb[j] = qg[d + 32]; gka[j] = kg[d]; gkb[j] = kg[d + 32]; }
    float w0[2][8], w1[2][8], w2[2][8], cg[2][8];
#pragma unroll
    for (int jc = 0; jc < 2; ++jc)
#pragma unroll
        for (int q = 0; q < 8; ++q) { const int ch = 8 * lane + 512 * jc + q; w0[jc][q] = cw[ch]; w1[jc][q] = cw[1024 + ch]; w2[jc][q] = cw[2048 + ch]; cg[jc][q] = cog[ch]; }
    for (int chunk0 = blockIdx.x; chunk0 < M / 64; chunk0 += G) { const int chunk = (G == 256) ? ((chunk0 & 7) << 5) + (chunk0 >> 3) : chunk0;
        const int row0 = chunk * 64 + wave * 8;
#pragma nounroll
        for (int g5 = 0; g5 < 10; g5 += 5) {
        u32x4 wa_[5], wb_[5];
#pragma unroll
        for (int ii = 0; ii < 5; ++ii) { const int i = g5 + ii;
            const bool isq = i < 8;
            const int row = isq ? row0 + i : row0 + (i - 8) * 4 + (lane >> 4);
            const int hcol = isq ? (lane >> 3) * HD : OFF_K + ((lane >> 3) & 1) * HD;
            const bf16_t* base = P + (size_t)row * PW + hcol + sq * 64 + 8 * cq;
            wa_[ii] = *(const u32x4*)base; wb_[ii] = *(const u32x4*)(base + 32); }
#pragma unroll
        for (int ii = 0; ii < 5; ++ii) { const int i = g5 + ii;
            const bool isq = i < 8;
            const int row = isq ? row0 + i : row0 + (i - 8) * 4 + (lane >> 4);
            const int t = row & (SEQ - 1), pos = sq ? (t & 63) : (t >> 6);
            bf16_t* obase = (isq ? Qo + (size_t)row * 1024 + (lane >> 3) * HD : KVo + (size_t)row * 512 + ((lane >> 3) & 1) * HD) + sq * 64 + 8 * cq;
            const u32x4 wa = wa_[ii], wb = wb_[ii];
            float xa[8], xb[8]; float ss = 0.f;
#pragma unroll
            for (int q = 0; q < 4; ++q) { xa[2 * q] = bf_lo(wa[q]); xa[2 * q + 1] = bf_hi(wa[q]); xb[2 * q] = bf_lo(wb[q]); xb[2 * q + 1] = bf_hi(wb[q]); }
#pragma unroll
            for (int j = 0; j < 8; ++j) ss += xa[j] * xa[j] + xb[j] * xb[j];
            ss += swz_xor<1>(ss); ss += swz_xor<2>(ss); ss += swz_xor<4>(ss);
            const float rs = rsqrtf(ss * (1.0f / HD) + EPS);
            const LAS f32x4* tp = (const LAS f32x4*)(tab + pos * 32 + 8 * cq);
            float ya[8], yb[8];
#pragma unroll
            for (int q = 0; q < 4; ++q) { const f32x4 cs = tp[q];
#pragma unroll
                for (int e = 0; e < 2; ++e) { const int j = 2 * q + e; const float co = e ? cs.z : cs.x, si = e ? cs.w : cs.y;
                    const float a_ = xa[j] * rs * (isq ? gqa[j] : gka[j]), b_ = xb[j] * rs * (isq ? gqb[j] : gkb[j]);
                    ya[j] = a_ * co - b_ * si; yb[j] = b_ * co + a_ * si; } }
            u32x4 oa, ob;
#pragma unroll
            for (int q = 0; q < 4; ++q) { oa[q] = cvt_pk_bf16(ya[2 * q], ya[2 * q + 1]); ob[q] = cvt_pk_bf16(yb[2 * q], yb[2 * q + 1]); }
            *(u32x4*)obase = oa; *(u32x4*)(obase + 32) = ob;
        } }
        if (lane < 32) {
#pragma unroll
            for (int i = 0; i < 8; ++i) *(u32x4*)(KVo + (size_t)(row0 + i) * 512 + 256 + 8 * lane) = *(const u32x4*)(P + (size_t)(row0 + i) * PW + OFF_V + 8 * lane); }
        static_assert(MK_UFUSE, "the conv stage reads the fused u = C * h columns");
        const int t0 = row0 & (SEQ - 1);
#pragma unroll
        for (int jc = 0; jc < 2; ++jc) { const int ch = 8 * lane + 512 * jc;
#pragma nounroll
            for (int hh = 0; hh < 2; ++hh) {
            u32x4 ur[6], gr[4];
#pragma unroll
            for (int r = 0; r < 6; ++r) { const bool ok = (r == 0) ? (hh == 1 || t0 > 0) : ((r == 5) ? (hh == 0 || t0 + 8 < SEQ) : true);
                if (ok) ur[r] = *(const u32x4*)(P + (size_t)(row0 + 4 * hh + r - 1) * PW + OFF_U + ch); else ur[r] = (u32x4){0u, 0u, 0u, 0u}; }
#pragma unroll
            for (int i = 0; i < 4; ++i) gr[i] = *(const u32x4*)(P + (size_t)(row0 + 4 * hh + i) * PW + 2560 + ch);
#pragma unroll
            for (int i = 0; i < 4; ++i) {
                float y[8]; float ss = 0.f;
#pragma unroll
                for (int q = 0; q < 8; ++q) { const unsigned wp = ur[i][q >> 1], wc_ = ur[i + 1][q >> 1], wn = ur[i + 2][q >> 1], wg = gr[i][q >> 1];
                    const float up_ = (q & 1) ? bf_hi(wp) : bf_lo(wp), uc_ = (q & 1) ? bf_hi(wc_) : bf_lo(wc_), un_ = (q & 1) ? bf_hi(wn) : bf_lo(wn), gb = (q & 1) ? bf_hi(wg) : bf_lo(wg);
                    y[q] = gb * (up_ * w0[jc][q] + uc_ * w1[jc][q] + un_ * w2[jc][q]); ss += y[q] * y[q]; }
                ss = sum16(ss);
                const float rs = rsqrtf(ss * (1.0f / 128.0f) + EPS);
                u32x4 o; o.x = cvt_pk_bf16(y[0] * rs * cg[jc][0], y[1] * rs * cg[jc][1]); o.y = cvt_pk_bf16(y[2] * rs * cg[jc][2], y[3] * rs * cg[jc][3]);
                o.z = cvt_pk_bf16(y[4] * rs * cg[jc][4], y[5] * rs * cg[jc][5]); o.w = cvt_pk_bf16(y[6] * rs * cg[jc][6], y[7] * rs * cg[jc][7]);
                *(u32x4*)(MIX + (size_t)(row0 + 4 * hh + i) * DM + 1024 + ch) = o; } } }
    }
}

__device__ __forceinline__ void combine_pass(KArgP a, int l, int G, int g_wave) {
    const int tid = opaque_tid(), lane = tid & 63, wave = __builtin_amdgcn_readfirstlane(tid >> 6);
    const int* posof = (const int*)(a->ws + WS_ROUTE + RT_POSOF); const f32x2* wts = (const f32x2*)(a->ws + WS_ROUTE + RT_WTS);
    const bf16_t* Y = (const bf16_t*)(a->ws + WS_Y); const float* modf = (const float*)(a->ws + WS_MODF);
    if (MK_XBF && !MK_Y8 && MK_CMBPIPE && M == 64 * G) {
        const bf16_t* XRp = (const bf16_t*)(a->ws + WS_XR);
        const int r0 = blockIdx.x * 8 + wave, st = G * 8;
        int q0[8], q1[8]; f32x2 ww[8];
#pragma unroll
        for (int k = 0; k < 8; ++k) { const int row = r0 + k * st; q0[k] = posof[row * 2]; q1[k] = posof[row * 2 + 1]; ww[k] = wts[row]; }
        u32x4 ay0[4], ay1[4], ax[4], by0[4], by1[4], bx[4]; f32x4 aga[4], agb[4], bga[4], bgb[4];
#define CMB_LOAD(Y0, Y1, X, GA, GB, k) do { const int row_ = r0 + (k) * st; const float* g2_ = modf + (size_t)(l * 8 + (row_ >> 11)) * MODW + 5 * DM; \
        _Pragma("unroll") for (int j = 0; j < 4; ++j) { const int col = 8 * lane + 512 * j; \
            Y0[j] = *(const u32x4*)(Y + (size_t)q0[k] * DM + col); Y1[j] = *(const u32x4*)(Y + (size_t)q1[k] * DM + col); X[j] = *(const u32x4*)(XRp + (size_t)row_ * DM + col); \
            GA[j] = *(const f32x4*)(g2_ + col); GB[j] = *(const f32x4*)(g2_ + col + 4); } } while (0)
#define CMB_DO(Y0, Y1, X, GA, GB, k) do { float* o_ = a->out + (size_t)(r0 + (k) * st) * DM; const f32x2 w_ = ww[k]; \
        _Pragma("unroll") for (int j = 0; j < 4; ++j) { const int col = 8 * lane + 512 * j; const u32x4 y0 = Y0[j], y1 = Y1[j], xw = X[j]; \
            const f32x4 ya0 = (f32x4){bf_lo(y0.x), bf_hi(y0.x), bf_lo(y0.y), bf_hi(y0.y)}, yb0 = (f32x4){bf_lo(y0.z), bf_hi(y0.z), bf_lo(y0.w), bf_hi(y0.w)}; \
            const f32x4 ya1 = (f32x4){bf_lo(y1.x), bf_hi(y1.x), bf_lo(y1.y), bf_hi(y1.y)}, yb1 = (f32x4){bf_lo(y1.z), bf_hi(y1.z), bf_lo(y1.w), bf_hi(y1.w)}; \
            const f32x4 xa = (f32x4){bf_lo(xw.x), bf_hi(xw.x), bf_lo(xw.y), bf_hi(xw.y)}, xb = (f32x4){bf_lo(xw.z), bf_hi(xw.z), bf_lo(xw.w), bf_hi(xw.w)}; \
            *(f32x4*)(o_ + col) = xa + GA[j] * (ya0 * w_.x + ya1 * w_.y); *(f32x4*)(o_ + col + 4) = xb + GB[j] * (yb0 * w_.x + yb1 * w_.y); } } while (0)
        CMB_LOAD(ay0, ay1, ax, aga, agb, 0);
#pragma unroll
        for (int k = 0; k < 8; k += 2) {
            CMB_LOAD(by0, by1, bx, bga, bgb, k + 1); __builtin_amdgcn_sched_barrier(0);
            CMB_DO(ay0, ay1, ax, aga, agb, k); __builtin_amdgcn_sched_barrier(0);
            if (k + 2 < 8) { CMB_LOAD(ay0, ay1, ax, aga, agb, k + 2); } __builtin_amdgcn_sched_barrier(0);
            CMB_DO(by0, by1, bx, bga, bgb, k + 1); __builtin_amdgcn_sched_barrier(0);
        }
#undef CMB_LOAD
#undef CMB_DO
        return;
    }
    for (int row = blockIdx.x * 8 + wave; row < M; row += G * 8) {
        const int b = row >> 11; const int p0 = posof[row * 2], p1 = posof[row * 2 + 1]; const f32x2 w = wts[row];
        const float* g2 = modf + (size_t)(l * 8 + b) * MODW + 5 * DM;
        float* o = a->out + (size_t)row * DM;
#pragma unroll
        for (int j = 0; j < 4; ++j) { const int col = 8 * lane + 512 * j;
            f32x4 ya0, yb0, ya1, yb1;
            if (MK_Y8) { const unsigned char* Y8 = (const unsigned char*)Y; const u32x2 q0 = *(const u32x2*)(Y8 + (size_t)p0 * DM + col), q1 = *(const u32x2*)(Y8 + (size_t)p1 * DM + col);
                const f32x2 a0 = __builtin_amdgcn_cvt_pk_f32_fp8((int)q0.x, false), a1 = __builtin_amdgcn_cvt_pk_f32_fp8((int)q0.x, true), a2 = __builtin_amdgcn_cvt_pk_f32_fp8((int)q0.y, false), a3 = __builtin_amdgcn_cvt_pk_f32_fp8((int)q0.y, true);
                const f32x2 b0 = __builtin_amdgcn_cvt_pk_f32_fp8((int)q1.x, false), b1 = __builtin_amdgcn_cvt_pk_f32_fp8((int)q1.x, true), b2 = __builtin_amdgcn_cvt_pk_f32_fp8((int)q1.y, false), b3 = __builtin_amdgcn_cvt_pk_f32_fp8((int)q1.y, true);
                constexpr float r = 1.0f / FP8_YSCALE;
                ya0 = (f32x4){a0.x, a0.y, a1.x, a1.y} * r; yb0 = (f32x4){a2.x, a2.y, a3.x, a3.y} * r; ya1 = (f32x4){b0.x, b0.y, b1.x, b1.y} * r; yb1 = (f32x4){b2.x, b2.y, b3.x, b3.y} * r; }
            else { const u32x4 y0 = *(const u32x4*)(Y + (size_t)p0 * DM + col), y1 = *(const u32x4*)(Y + (size_t)p1 * DM + col);
                ya0 = (f32x4){bf_lo(y0.x), bf_hi(y0.x), bf_lo(y0.y), bf_hi(y0.y)}; yb0 = (f32x4){bf_lo(y0.z), bf_hi(y0.z), bf_lo(y0.w), bf_hi(y0.w)};
                ya1 = (f32x4){bf_lo(y1.x), bf_hi(y1.x), bf_lo(y1.y), bf_hi(y1.y)}; yb1 = (f32x4){bf_lo(y1.z), bf_hi(y1.z), bf_lo(y1.w), bf_hi(y1.w)}; }
            const f32x4 ga = *(const f32x4*)(g2 + col), gb = *(const f32x4*)(g2 + col + 4);
            f32x4 xa, xb;
            if (MK_XBF) { const u32x4 w_ = *(const u32x4*)((const bf16_t*)(a->ws + WS_XR) + (size_t)row * DM + col); xa = (f32x4){bf_lo(w_.x), bf_hi(w_.x), bf_lo(w_.y), bf_hi(w_.y)}; xb = (f32x4){bf_lo(w_.z), bf_hi(w_.z), bf_lo(w_.w), bf_hi(w_.w)}; }
            else { xa = *(const f32x4*)(o + col); xb = *(const f32x4*)(o + col + 4); }
            xa = xa + ga * (ya0 * w.x + ya1 * w.y); xb = xb + gb * (yb0 * w.x + yb1 * w.y);
            *(f32x4*)(o + col) = xa; *(f32x4*)(o + col + 4) = xb; }
    }
}

constexpr int NPHASE = 21;
__global__ void __launch_bounds__(512, 2) mk_fwd(Args args) {
    extern __shared__ __attribute__((aligned(16))) unsigned char lds_raw[];
    LAS unsigned char* lds = (LAS unsigned char*)lds_raw;
    const int tid = threadIdx.x, G = gridDim.x;
    const int g_wave = __builtin_amdgcn_readfirstlane(tid >> 6);
    volatile LAS unsigned* MISC = (volatile LAS unsigned*)(lds + MISC_OFF);
    for (int u = tid; u < (LDS_BYTES - LDSCTL_OFF) / 4; u += 512) ((LAS unsigned*)(lds + LDSCTL_OFF))[u] = 0u;
    __syncthreads();
    const int lo = args.ph_lo, hi = args.ph_hi;
    unsigned* barw = (unsigned*)(args.ws + WS_CTL) + CW_BAR;
    XcdBarrier bar; bar.bar = barw; bar.x = 0; bar.st = nullptr;
    if (hi - lo > 1) bar = xcd_barrier_post(barw, MISC + 8, g_wave);
#ifndef MK_EN
#define MK_EN 0xffffffffu
#endif
#define EN(k) (((MK_EN) >> (k)) & 1u)
#define IN(p) (lo <= (p) && (p) < hi)
#define SEAM(p) do { if ((p) + 1 < hi) xcd_barrier(bar, g_wave); } while (0)
#define A_ (*ap_)
#define WSP(T, off) ((T*)(A_.ws + (off)))

#ifndef MK_DUP
#define MK_DUP 0u
#endif
#define DUP(k) (((MK_DUP) >> (k)) & 1u)
#ifndef MK_VAR
#define MK_VAR 0
#endif
#define PHASE(kind, pid, ...) do { if (EN(kind) && IN(pid)) { _Pragma("nounroll") for (int rep_ = 0; rep_ <= (int)DUP(kind); ++rep_) { if (rep_) xcd_barrier(bar, g_wave); { const KArgP ap_ = kargs(); __VA_ARGS__ } } SEAM(pid); } } while (0)
    PHASE(0, 0, p0_prologue(ap_, lds, G, g_wave, rep_ ? MK_VAR : 0););

    for (int l = 0; l < 2; ++l) {
        const int pb = 1 + 10 * l;
        if (!(l == 1 && MK_NFUSE && G == 256 && MK_FP8_DDN && MK_XBF && !MK_FP8_QKV))
        PHASE(1, pb + 0, if (l == 0) norm_pass<true, false, MK_FP8_QKV ? 2 : 0>(ap_, l, 0, A_.in[I_X], lds, G, g_wave); else norm_pass<false, false, MK_FP8_QKV ? 2 : 0, MK_XBF != 0>(ap_, l, 0, MK_XBF ? (const void*)WSP(bf16_t, WS_XR) : (const void*)A_.out, lds, G, g_wave););
        PHASE(2, pb + 1,
            constexpr int CV_P0END = CV_WOUT0 + (int)((long)(CV_END - CV_WOUT0) * MK_CVP0 / 100), CV_SPLIT = CV_P0END + (CV_END - CV_P0END) / 2;
            static_assert(CV_SPLIT >= CV_MG, "everything used before the MoE is converted in the prologue or in layer 0");
            const int jx = (int)blockIdx.x >> 3; const int xx = (int)blockIdx.x & 7;
            const bool cvwg = MK_CVSPLIT && G == 256 && (jx & 3) == 3;
            const int gG = (MK_CVSPLIT && G == 256) ? 192 : G; const int gc = (MK_CVSPLIT && G == 256) ? (jx - (jx >> 2)) * 8 + xx : (int)blockIdx.x;
            if (cvwg) { if (rep_ == 0) { convert_items(ap_, lds, (jx >> 2) * 8 + xx, 64, g_wave, l == 0 ? CV_P0END : CV_SPLIT, l == 0 ? CV_SPLIT : CV_END);
                if (MK_VAR == 20) { __syncthreads(); convert_items(ap_, lds, (jx >> 2) * 8 + xx, 64, g_wave, l == 0 ? CV_P0END : CV_SPLIT, l == 0 ? CV_SPLIT : CV_END); } } }
            else {
                pg8::Gemm g{WSP(bf16_t, WS_H), WSP(bf16_t, WS_WIN) + (size_t)l * IN_W * DM, 2 * DM}; pg8::DenseOrder S; S.init(M / 256, IN_W / 256, gG, gc, MK_WGM_IN);
#if MK_UFUSE
                pg8::EpiInProj E{WSP(bf16_t, WS_P)};
                pg8::gemm_phase<pg8::EpiInProj, pg8::DenseOrder, true, true, false>(lds, g, S, E, g_wave);
#else
                pg8::EpiStoreBf16 E{WSP(bf16_t, WS_P), IN_W, 0, 1.0f};
                pg8::gemm_phase<pg8::EpiStoreBf16, pg8::DenseOrder, true, true, false>(lds, g, S, E, g_wave);
#endif
            }
            if (!MK_CVSPLIT && l == 0 && rep_ == 0) { }
            );
        PHASE(3, pb + 2, prep_pass(ap_, l, lds, G, g_wave); if (MK_VAR == 21) { for (int xb = 0; xb < 9; ++xb) xcd_barrier(bar, g_wave); });
        PHASE(4, pb + 3,
            const float* aog = A_.in[I_AOG] + (size_t)l * 1024; const bf16_t* Qm = WSP(bf16_t, WS_Q); const bf16_t* KVm = WSP(bf16_t, WS_KV); bf16_t* MIX = WSP(bf16_t, WS_MIX);
            for (int i = 0; ; ++i) { const int L = i * G + (int)blockIdx.x; if (L >= BATCH * NHEAD * (SEQ / 256)) break;
                const int b = L & 7; const int j = (L >> 3) & 31; const int kvh = L >> 8; const int h = kvh * 4 + (j >> 3); const int qb = j & 7;
                const bf16_t* Qb = Qm + (size_t)(b * SEQ + qb * 256) * attn::LDQ + h * HD;
                const bf16_t* Kh = KVm + (size_t)(b * SEQ) * attn::LDKV + kvh * HD;
                const bf16_t* Vh = KVm + (size_t)(b * SEQ) * attn::LDKV + 256 + kvh * HD;
                bf16_t* Ob = MIX + (size_t)(b * SEQ + qb * 256) * DM + h * HD;
                attn::attn_unit(Qb, Kh, Vh, Ob, aog + h * HD, SEQ, (char*)lds_raw, g_wave);
                __syncthreads();
            });
        PHASE(5, pb + 4,
            pg8::Gemm g{WSP(bf16_t, WS_MIX), WSP(bf16_t, WS_WOUT) + (size_t)l * DM * DM, 2 * DM}; pg8::DenseOrder S; S.init(M / 256, DM / 256, G, (int)blockIdx.x, MK_WGM_OUT);
            const float* g1 = WSP(float, WS_MODF) + (size_t)l * 8 * MODW + 2 * DM;
#if MK_XBF
            if (l == 0 && MK_NFUSE && G == 256 && MK_WGM_OUT == 4) {
                pg8::EpiResidNorm<true, MK_FP8_DUP != 0> E{A_.in[I_X], WSP(bf16_t, WS_XR), g1, 1.0f, A_.in[I_N2G], WSP(float, WS_MODF), 3 * DM, 4 * DM,
                    WSP(void, WS_H), WSP(float, WS_XS), WSP(unsigned, WS_CTL) + CW_NCNT, barw + XB_TMO, lds + RING_BYTES};
                pg8::gemm_phase<pg8::EpiResidNorm<true, MK_FP8_DUP != 0>, pg8::DenseOrder, true, true, false>(lds, g, S, E, g_wave); }
            else if (l == 0) { pg8::EpiResidBf<true> E{A_.in[I_X], WSP(bf16_t, WS_XR), g1, 1.0f}; pg8::gemm_phase<pg8::EpiResidBf<true>, pg8::DenseOrder, true, true, false>(lds, g, S, E, g_wave); }
            else { pg8::EpiResidBf<false> E{WSP(bf16_t, WS_XR), WSP(bf16_t, WS_XR), g1, 1.0f}; pg8::gemm_phase<pg8::EpiResidBf<false>, pg8::DenseOrder, true, true, false>(lds, g, S, E, g_wave); }
#else
            const float* xin = l ? A_.out : A_.in[I_X];
            pg8::EpiResid E{xin, A_.out, g1, 1.0f};
            pg8::gemm_phase<pg8::EpiResid, pg8::DenseOrder, true, true, false>(lds, g, S, E, g_wave);
#endif
            );
        if (!(l == 0 && MK_NFUSE && G == 256 && MK_WGM_OUT == 4))
        PHASE(6, pb + 5, const void* xr2 = MK_XBF ? (const void*)WSP(bf16_t, WS_XR) : (const void*)A_.out; if (l == 0) norm_pass<false, false, MK_FP8_DUP ? 1 : 0, MK_XBF != 0>(ap_, l, 1, xr2, lds, G, g_wave); else norm_pass<false, true, MK_FP8_MOE ? 1 : 0, MK_XBF != 0>(ap_, l, 1, xr2, lds, G, g_wave););
        if (l == 0) {
            PHASE(8, pb + 7,
                pg8::DenseOrder S; S.init(M / 256, 2 * FFD / 256, G, (int)blockIdx.x, MK_WGM_UP);
#if MK_FP8_DUP
                pg8::Gemm g{WSP(void, WS_H), WSP(void, WS_DGU), DM};
                pg8::EpiSwiGLU8T<MK_FP8_DDN != 0> E{WSP(void, WS_HID), FFD, FP8_DESCALE, MK_FP8_DDN ? FP8_ASCALE : 1.0f};
                pg8::gemm_phase<pg8::EpiSwiGLU8T<MK_FP8_DDN != 0>, pg8::DenseOrder, true, true, false, 0, true>(lds, g, S, E, g_wave);
#else
                pg8::Gemm g{WSP(bf16_t, WS_H), WSP(bf16_t, WS_DGU), 2 * DM};
                pg8::EpiSwiGLU E{WSP(bf16_t, WS_HID), FFD};
                pg8::gemm_phase<pg8::EpiSwiGLU, pg8::DenseOrder, true, true, false>(lds, g, S, E, g_wave);
#endif
                );
            PHASE(9, pb + 8,
                pg8::DenseOrder S; S.init(M / 256, DM / 256, G, (int)blockIdx.x, (MK_NFUSE && G == 256) ? 4 : MK_WGM_DN);
#if MK_FP8_DDN && MK_XBF
                pg8::Gemm g{WSP(void, WS_HID), WSP(void, WS_DDN), FFD};
                if (MK_NFUSE && G == 256) {
                    pg8::EpiResidNorm<false, false> E{WSP(bf16_t, WS_XR), WSP(bf16_t, WS_XR), WSP(float, WS_MODF) + (size_t)l * 8 * MODW + 5 * DM, FP8_DESCALE, A_.in[I_N1G] + DM, WSP(float, WS_MODF) + (size_t)8 * MODW, 0, DM,
                        WSP(void, WS_H), WSP(float, WS_XS) + 64 * 256 * 8, WSP(unsigned, WS_CTL) + CW_NCNT + 4096, barw + XB_TMO, lds + RING_BYTES};
                    pg8::gemm_phase<pg8::EpiResidNorm<false, false>, pg8::DenseOrder, true, true, false, 0, true>(lds, g, S, E, g_wave);
                } else {
                pg8::EpiResidBf<false> E{WSP(bf16_t, WS_XR), WSP(bf16_t, WS_XR), WSP(float, WS_MODF) + (size_t)l * 8 * MODW + 5 * DM, FP8_DESCALE};
                pg8::gemm_phase<pg8::EpiResidBf<false>, pg8::DenseOrder, true, true, false, 0, true>(lds, g, S, E, g_wave); }
#elif MK_FP8_DDN
                pg8::Gemm g{WSP(void, WS_HID), WSP(void, WS_DDN), FFD};
                pg8::EpiResid E{A_.out, A_.out, WSP(float, WS_MODF) + (size_t)l * 8 * MODW + 5 * DM, FP8_DESCALE};
                pg8::gemm_phase<pg8::EpiResid, pg8::DenseOrder, true, true, false, 0, true>(lds, g, S, E, g_wave);
#else
                pg8::Gemm g{WSP(bf16_t, WS_HID), WSP(bf16_t, WS_DDN), 2 * FFD};
                pg8::EpiResid E{A_.out, A_.out, WSP(float, WS_MODF) + (size_t)l * 8 * MODW + 5 * DM, 1.0f};
                pg8::gemm_phase<pg8::EpiResid, pg8::DenseOrder, true, true, false>(lds, g, S, E, g_wave);
#endif
                );
        } else {
            PHASE(7, pb + 6, route_pass(ap_, lds, G, g_wave););
            PHASE(10, pb + 7,
                const int* tsv = WSP(const int, WS_ROUTE + RT_TS);
                pg8::MoeOrder S; S.init(RFL(tsv[8]), 2 * FFE / 256, G, (int)blockIdx.x, MK_WGM_UP);
                S.t1 = RFL(tsv[1]); S.t2 = RFL(tsv[2]); S.t3 = RFL(tsv[3]); S.t4 = RFL(tsv[4]); S.t5 = RFL(tsv[5]); S.t6 = RFL(tsv[6]); S.t7 = RFL(tsv[7]); S.rowlist = WSP(const int, WS_ROUTE + RT_ROWLIST);
#if MK_FP8_MOE
                pg8::Gemm g{WSP(void, WS_H), WSP(void, WS_MGU), DM};
                pg8::EpiSwiGLU8 E{WSP(unsigned char, WS_HID), FFE, FP8_DESCALE, FP8_ASCALE};
                pg8::gemm_phase<pg8::EpiSwiGLU8, pg8::MoeOrder, true, true, true, 0, true>(lds, g, S, E, g_wave);
#else
                pg8::Gemm g{WSP(void, WS_H), WSP(void, WS_MGU), 2 * DM};
                pg8::EpiSwiGLU E{WSP(bf16_t, WS_HID), FFE};
                pg8::gemm_phase<pg8::EpiSwiGLU, pg8::MoeOrder, true, true, true>(lds, g, S, E, g_wave);
#endif
                );
            PHASE(11, pb + 8,
                const int* tsv = WSP(const int, WS_ROUTE + RT_TS);
                pg8::MoeOrder S; S.init(RFL(tsv[8]), DM / 256, G, (int)blockIdx.x, MK_WGM_DN);
                S.t1 = RFL(tsv[1]); S.t2 = RFL(tsv[2]); S.t3 = RFL(tsv[3]); S.t4 = RFL(tsv[4]); S.t5 = RFL(tsv[5]); S.t6 = RFL(tsv[6]); S.t7 = RFL(tsv[7]); S.rowlist = nullptr;
#if MK_FP8_MOE && MK_Y8
                pg8::Gemm g{WSP(void, WS_HID), WSP(void, WS_MDN), FFE};
                pg8::EpiStoreFp8 E{WSP(unsigned char, WS_Y), DM, FP8_DESCALE * FP8_YSCALE};
                pg8::gemm_phase<pg8::EpiStoreFp8, pg8::MoeOrder, true, true, false, 0, true>(lds, g, S, E, g_wave);
#elif MK_FP8_MOE
                pg8::Gemm g{WSP(void, WS_HID), WSP(void, WS_MDN), FFE};
                pg8::EpiStoreBf16T<true> E{WSP(bf16_t, WS_Y), DM, 0, FP8_DESCALE};
                pg8::gemm_phase<pg8::EpiStoreBf16T<true>, pg8::MoeOrder, true, true, false, 0, true>(lds, g, S, E, g_wave);
#else
                pg8::Gemm g{WSP(void, WS_HID), WSP(void, WS_MDN), 2 * FFE};
                pg8::EpiStoreBf16 E{WSP(bf16_t, WS_Y), DM, 0, 1.0f};
                pg8::gemm_phase<pg8::EpiStoreBf16, pg8::MoeOrder, true, true, false>(lds, g, S, E, g_wave);
#endif
                );
            PHASE(12, pb + 9, combine_pass(ap_, l, G, g_wave););
        }
    }
#undef PHASE
#undef A_
#undef WSP
#undef IN
#undef SEAM
}

extern "C" void kernel_launch(void* const* d_in, const int* in_sizes, int n_in, void* d_out, int out_size, void* d_ws, size_t ws_size, hipStream_t stream) {
    static int grid = 0;
    if (grid == 0) {
        if (n_in != 20 || in_sizes[0] != M * DM || out_size != M * DM || ws_size < WS_END) { fprintf(stderr, "kernel_launch: unexpected shapes (n_in %d in0 %d out %d ws %zu need %zu); nothing launched\n", n_in, n_in > 0 ? in_sizes[0] : -1, out_size, ws_size, (size_t)WS_END); grid = -1; return; }
        int dev = 0, cus = 0, per_cu = 0;
        if (hipGetDevice(&dev) != hipSuccess || hipDeviceGetAttribute(&cus, hipDeviceAttributeMultiprocessorCount, dev) != hipSuccess) { grid = -1; return; }
        if (hipFuncSetAttribute((const void*)mk_fwd, hipFuncAttributeMaxDynamicSharedMemorySize, LDS_BYTES) != hipSuccess) { fprintf(stderr, "kernel_launch: hipFuncSetAttribute failed\n"); grid = -1; return; }
        if (hipOccupancyMaxActiveBlocksPerMultiprocessor(&per_cu, (const void*)mk_fwd, 512, LDS_BYTES) != hipSuccess || per_cu < 1) fprintf(stderr, "kernel_launch: occupancy query says %d blocks per CU\n", per_cu);
        (void)hipGetLastError();
        grid = cus < 256 ? cus : 256;
    }
    if (grid < 0) return;
    if (hipMemsetAsync((char*)d_ws + WS_CTL, 0, CTL_ZERO_BYTES, stream) != hipSuccess) return;
    Args a{};
    for (int i = 0; i < 20; ++i) a.in[i] = (const float*)d_in[i];
    a.out = (float*)d_out; a.ws = (unsigned char*)d_ws;
#if MK_MULTI
    for (int p = 0; p < NPHASE; ++p) {
        if (p == 7 || p == 10) continue;
        a.ph_lo = p; a.ph_hi = p + 1;
        hipLaunchKernelGGL(mk_fwd, dim3(grid), dim3(512), LDS_BYTES, stream, a);
    }
#else
    a.ph_lo = 0; a.ph_hi = NPHASE;
    hipLaunchKernelGGL(mk_fwd, dim3(grid), dim3(512), LDS_BYTES, stream, a);
#endif
    const hipError_t le = hipPeekAtLastError();
    if (le != hipSuccess) fprintf(stderr, "kernel_launch: launch failed: %s\n", hipGetErrorName(le));
}
```

```cpp
#include <hip/hip_runtime.h>
#include <hip/hip_bf16.h>
#include <cstdio>
#include <cstdint>

#ifndef MK_MULTI
#define MK_MULTI 0
#endif

#ifndef MK_FP8_MOE
#define MK_FP8_MOE 1
#endif
#ifndef MK_FP8_DUP
#define MK_FP8_DUP 1
#endif
#ifndef MK_FP8_DDN
#define MK_FP8_DDN 1
#endif
#ifndef MK_FP8_QKV
#define MK_FP8_QKV 0
#endif
#ifndef MK_WGM_IN
#define MK_WGM_IN 6
#endif
#ifndef MK_WGM_OUT
#define MK_WGM_OUT 4
#endif
#ifndef MK_WGM_UP
#define MK_WGM_UP 8
#endif
#ifndef MK_WGM_DN
#define MK_WGM_DN 8
#endif
#ifndef MK_UFUSE
#define MK_UFUSE 1
#endif
#ifndef MK_Y8
#define MK_Y8 0
#endif
#ifndef MK_XBF
#define MK_XBF 1
#endif
#ifndef MK_CVP0
#define MK_CVP0 0
#endif
#ifndef MK_CVSPLIT
#define MK_CVSPLIT 1
#endif
#define LAS __attribute__((address_space(3)))
#define GAS __attribute__((address_space(1)))
typedef unsigned short bf16_t;
typedef short bf16x8 __attribute__((ext_vector_type(8)));
typedef short s16x4 __attribute__((ext_vector_type(4)));
typedef float f32x4 __attribute__((ext_vector_type(4)));
typedef float f32x2 __attribute__((ext_vector_type(2)));
typedef float f32x16 __attribute__((ext_vector_type(16)));
typedef unsigned u32x4 __attribute__((ext_vector_type(4)));
typedef unsigned u32x2 __attribute__((ext_vector_type(2)));
typedef int v4i __attribute__((ext_vector_type(4)));
typedef int v8i __attribute__((ext_vector_type(8)));
constexpr float FP8_YSCALE = 16.0f;
constexpr float FP8_WSCALE = 256.0f, FP8_ASCALE = 8.0f, FP8_DESCALE = 1.0f / 2048.0f;
__device__ __forceinline__ float clamp448(float x) { return __builtin_amdgcn_fmed3f(x, -448.0f, 448.0f); }
__device__ __forceinline__ unsigned pk4_fp8(float a, float b, float c, float d) { int r = 0; r = __builtin_amdgcn_cvt_pk_fp8_f32(clamp448(a), clamp448(b), r, false); r = __builtin_amdgcn_cvt_pk_fp8_f32(clamp448(c), clamp448(d), r, true); return (unsigned)r; }

constexpr int BATCH = 8, SEQ = 2048, DM = 2048, M = BATCH * SEQ;
constexpr int NHEAD = 8, NKV = 2, HD = 128, IN_W = 4608;
constexpr int OFF_K = 1024, OFF_V = 1280, OFF_HC = 1536, OFF_GB = 2560, OFF_GC = 3584;
constexpr int QKV_W = 1536;
constexpr int PW = MK_UFUSE ? 3584 : 4608;
constexpr int OFF_U = 1536, OFF_GB2 = MK_UFUSE ? 2560 : 2560;
constexpr int FFD = 5632, NEXP = 8, FFE = 4096;
constexpr int MOE_TILES = 136, MOE_ROWS = MOE_TILES * 256;
constexpr float EPS = 1e-6f;
constexpr int MODW = 6 * DM;

constexpr size_t MiB = 1u << 20;
constexpr size_t WS_CTL = 0, CTL_ZERO_BYTES = 1 * MiB;
constexpr size_t WS_MODP = 1 * MiB;
constexpr size_t WS_MODF = 7 * MiB;
constexpr size_t WS_ROUTE = 8 * MiB;
constexpr size_t RT_SEL = 0, RT_WTS = 64 * 1024, RT_POSOF = 192 * 1024, RT_ROWLIST = 320 * 1024, RT_TS = 512 * 1024;
constexpr size_t WS_WIN8 = 9 * MiB;
constexpr size_t WS_WIN = 16 * MiB;
constexpr size_t WS_WOUT = 52 * MiB;
constexpr size_t WS_DGU = 68 * MiB;
constexpr size_t WS_DDN = 112 * MiB;
constexpr size_t WS_MGU = 134 * MiB;
constexpr size_t WS_MDN = 390 * MiB;
constexpr size_t WS_H = 518 * MiB;
constexpr size_t WS_P = 582 * MiB;
constexpr size_t WS_MIX = 726 * MiB;
constexpr size_t WS_HID = 790 * MiB;
constexpr size_t WS_Y = 1062 * MiB;
constexpr size_t WS_Q = 1198 * MiB;
constexpr size_t WS_KV = 1230 * MiB;
constexpr size_t WS_H8 = 1246 * MiB;
constexpr size_t WS_XR = 1246 * MiB;
constexpr size_t WS_XS = 1310 * MiB;
constexpr size_t WS_END = 1311 * MiB;
static_assert(!(MK_XBF && MK_FP8_QKV), "WS_XR overlays WS_H8");
static_assert(!MK_XBF || MK_FP8_DDN, "the bf16 residual stream is wired for the fp8 dense-down GEMM");
constexpr int CW_BAR = 4096;
constexpr int CW_NCNT = 16384;

constexpr int RING_BYTES = 131072;
constexpr int LDSCTL_OFF = 143360, MISC_OFF = LDSCTL_OFF + 320;
constexpr int LDS_BYTES = 147456;

#define RFL(x) __builtin_amdgcn_readfirstlane(x)
#define LDS_WAIT() asm volatile("s_waitcnt lgkmcnt(0)" ::: "memory")
#define VM_WAIT() asm volatile("s_waitcnt vmcnt(0)" ::: "memory")
#define RLX_AGENT __ATOMIC_RELAXED, __HIP_MEMORY_SCOPE_AGENT

__device__ __forceinline__ unsigned cvt_pk_bf16(float lo, float hi) { unsigned r; asm volatile("v_cvt_pk_bf16_f32 %0, %1, %2" : "=v"(r) : "v"(lo), "v"(hi)); return r; }
__device__ __forceinline__ int lane_id() { int l; asm volatile("v_mbcnt_lo_u32_b32 %0, -1, 0\n\tv_mbcnt_hi_u32_b32 %0, -1, %0" : "=v"(l)); return l; }
__device__ __forceinline__ int opaque_tid_w(int wave_s) { int t = wave_s * 64 + lane_id(); asm volatile("" : "+v"(t)); return t; }
#define opaque_tid() opaque_tid_w(g_wave)
#define MY_TID() (g_wave * 64 + lane_id())
__device__ __forceinline__ float bf_lo(unsigned w) { return __uint_as_float(w << 16); }
__device__ __forceinline__ float bf_hi(unsigned w) { return __uint_as_float(w & 0xffff0000u); }
template <int K> __device__ __forceinline__ float swz_xor(float v) { return __int_as_float(__builtin_amdgcn_ds_swizzle(__float_as_int(v), (K << 10) | 0x1f)); }
__device__ __forceinline__ float half_sum(float v) { v += swz_xor<1>(v); v += swz_xor<2>(v); v += swz_xor<4>(v); v += swz_xor<8>(v); v += swz_xor<16>(v); return v; }
__device__ __forceinline__ float sum16(float v) { v += swz_xor<1>(v); v += swz_xor<2>(v); v += swz_xor<4>(v); v += swz_xor<8>(v); return v; }
__device__ __forceinline__ float wave_sum(float v) {
    v = half_sum(v);
    auto rr = __builtin_amdgcn_permlane32_swap(__float_as_uint(v), __float_as_uint(v), false, false);
    return __uint_as_float(rr[0]) + __uint_as_float(rr[1]);
}

#ifndef MK_NFUSE
#define MK_NFUSE 1
#endif
#ifndef MK_CMBPIPE
#define MK_CMBPIPE 1
#endif
#ifndef MK_WT
#define MK_WT 0
#endif
__device__ __forceinline__ void st16(void* p, u32x4 v) { if (MK_WT) asm volatile("global_store_dwordx4 %0, %1, off sc1" :: "v"(p), "v"(v) : "memory"); else *(u32x4*)p = v; }
__device__ __forceinline__ void st16f(void* p, f32x4 v) { if (MK_WT) asm volatile("global_store_dwordx4 %0, %1, off sc1" :: "v"(p), "v"(v) : "memory"); else *(f32x4*)p = v; }
__device__ __forceinline__ void st8(void* p, u32x2 v) { if (MK_WT) asm volatile("global_store_dwordx2 %0, %1, off sc1" :: "v"(p), "v"(v) : "memory"); else *(u32x2*)p = v; }

namespace pg8 {
constexpr int BM = 256, BK = 64, HALF = 128, HTB = HALF * BK * 2, STAGE_BYTES = 8 * HTB, NXCD = 8;
__host__ __device__ __forceinline__ int lds_byte(int r, int c) { const int st = (r >> 4) * 2 + (c >> 5), rr = r & 15, cc = c & 31, ob = rr * 64 + cc * 2; return st * 1024 + (ob ^ (((ob >> 9) & 1) << 5)); }
__host__ __device__ __forceinline__ void stage_rc(int b, int& R, int& C) { const int st = b / 1024, sb = b % 1024, swz = sb ^ (((sb >> 9) & 1) << 5); R = (st >> 1) * 16 + swz / 64; C = (st & 1) * 32 + (swz % 64) / 2; }
__host__ __device__ __forceinline__ int perm32(int rho) { const int n = rho >> 4, i = rho & 15; return 8 * (i >> 2) + 4 * n + (i & 3); }

struct Unit { int pm, pn, pb; };
struct Gemm { const void* A; const void* Bt; int KB; };

struct StaticOrder {
    int nM, nN, nwg, G, c, WGM;
    __device__ __forceinline__ void init(int nM_, int nN_, int G_, int c_, int wgm = 4) { nM = nM_; nN = nN_; nwg = nM * nN; G = G_; c = c_; WGM = wgm; }
    __device__ __forceinline__ bool next_mn(int i, int& pm, int& pn) const {
        const long L = (long)i * G + c; if (L >= nwg) return false;
        int wgid = (int)L; { const int q = nwg / NXCD, r = nwg % NXCD, xcd = wgid % NXCD, off = wgid / NXCD; wgid = (xcd < r ? xcd * (q + 1) : r * (q + 1) + (xcd - r) * q) + off; }
        const int nig = WGM * nN, gid = wgid / nig, fm = gid * WGM, gsz = (nM - fm) < WGM ? (nM - fm) : WGM;
        pm = fm + ((wgid % nig) % gsz); pn = (wgid % nig) / gsz; return true;
    }
};
struct DenseOrder : StaticOrder {
    __device__ __forceinline__ bool next(int i, Unit& u) const { if (!next_mn(i, u.pm, u.pn)) return false; u.pb = u.pn; return true; }
    __device__ __forceinline__ int arow(const Unit& u, int r) const { return u.pm * BM + r; }
};
struct MoeOrder : StaticOrder {
    int t1, t2, t3, t4, t5, t6, t7; const int* rowlist;
    __device__ __forceinline__ int expert(int pm) const { return (pm >= t1) + (pm >= t2) + (pm >= t3) + (pm >= t4) + (pm >= t5) + (pm >= t6) + (pm >= t7); }
    __device__ __forceinline__ bool next(int i, Unit& u) const { if (!next_mn(i, u.pm, u.pn)) return false; u.pb = __builtin_amdgcn_readfirstlane(expert(u.pm)) * nN + u.pn; return true; }
    __device__ __forceinline__ int arow(const Unit& u, int r) const { return rowlist[u.pm * BM + r]; }
};

template <bool SCALED> struct EpiStoreBf16T {
    static constexpr bool PERM = true;
    bf16_t* O; int ldc; int skip; float scale;
    __device__ __forceinline__ void operator()(const f32x4 (&acc)[2][2][4][2], const Unit& u, int wr, int wc, int fr, int fq) const {
        if (skip) return;
        const int row0 = u.pm * BM + wr * 64 + fr, col0 = u.pn * BM + wc * 32 + 8 * fq;
#pragma unroll
        for (int ai = 0; ai < 2; ++ai)
#pragma unroll
            for (int m = 0; m < 4; ++m) { bf16_t* rowp = O + (size_t)(row0 + ai * HALF + m * 16) * ldc + col0;
#pragma unroll
                for (int bj = 0; bj < 2; ++bj) { f32x4 v0 = acc[ai][bj][m][0], v1 = acc[ai][bj][m][1]; if (SCALED) { v0 = v0 * scale; v1 = v1 * scale; }
                    u32x4 w; w.x = cvt_pk_bf16(v0[0], v0[1]); w.y = cvt_pk_bf16(v0[2], v0[3]); w.z = cvt_pk_bf16(v1[0], v1[1]); w.w = cvt_pk_bf16(v1[2], v1[3]);
                    st16(rowp + bj * HALF, w); } }
    }
};
typedef EpiStoreBf16T<false> EpiStoreBf16;
__device__ __forceinline__ float silu_mul(float g, float u) { return g * __builtin_amdgcn_rcpf(1.0f + __builtin_amdgcn_exp2f(-1.4426950408889634f * g)) * u; }
__device__ __forceinline__ float silu_mul_s(float a, float b, float c1, float kc) {
    float t, p;
    asm("v_mul_f32 %0, %3, %2\n\tv_exp_f32 %0, %0\n\tv_mul_f32 %1, %2, %4\n\ts_nop 0\n\tv_fma_f32 %0, %0, %5, %5\n\tv_rcp_f32 %0, %0\n\ts_nop 1\n\tv_mul_f32 %1, %1, %0"
        : "=&v"(t), "=&v"(p) : "v"(a), "s"(c1), "v"(b), "s"(kc));
    return p;
}
struct EpiSwiGLU {
    static constexpr bool PERM = true;
    bf16_t* O; int ldc;
    __device__ __forceinline__ void operator()(const f32x4 (&acc)[2][2][4][2], const Unit& u, int wr, int wc, int fr, int fq) const {
        const int row0 = u.pm * BM + wr * 64 + fr, col0 = u.pn * HALF + wc * 32 + 8 * fq;
#pragma unroll
        for (int ai = 0; ai < 2; ++ai)
#pragma unroll
            for (int m = 0; m < 4; ++m) { bf16_t* rowp = O + (size_t)(row0 + ai * HALF + m * 16) * ldc + col0;
                const f32x4 g0 = acc[ai][0][m][0], g1 = acc[ai][0][m][1], u0 = acc[ai][1][m][0], u1 = acc[ai][1][m][1];
                u32x4 w; w.x = cvt_pk_bf16(silu_mul(g0[0], u0[0]), silu_mul(g0[1], u0[1])); w.y = cvt_pk_bf16(silu_mul(g0[2], u0[2]), silu_mul(g0[3], u0[3]));
                w.z = cvt_pk_bf16(silu_mul(g1[0], u1[0]), silu_mul(g1[1], u1[1])); w.w = cvt_pk_bf16(silu_mul(g1[2], u1[2]), silu_mul(g1[3], u1[3]));
                *(u32x4*)rowp = w; }
    }
};
template <bool OUT8> struct EpiSwiGLU8T {
    static constexpr bool PERM = true;
    void* O; int ldc; float descale, oscale;
    __device__ __forceinline__ void operator()(const f32x4 (&acc)[2][2][4][2], const Unit& u, int wr, int wc, int fr, int fq) const {
        const int row0 = u.pm * BM + wr * 64 + fr, col0 = u.pn * HALF + wc * 32 + 8 * fq;
        const float c1 = -1.4426950408889634f * descale, kc = 1.0f / (descale * descale * oscale);
#pragma unroll
        for (int ai = 0; ai < 2; ++ai)
#pragma unroll
            for (int m = 0; m < 4; ++m) { const size_t eo = (size_t)(row0 + ai * HALF + m * 16) * ldc + col0;
                const f32x4 a0 = acc[ai][0][m][0], a1 = acc[ai][0][m][1], b0 = acc[ai][1][m][0], b1 = acc[ai][1][m][1];
                if (OUT8) {
                    float s0[4], s1[4];
#pragma unroll
                    for (int j = 0; j < 4; ++j) { s0[j] = silu_mul_s(a0[j], b0[j], c1, kc); s1[j] = silu_mul_s(a1[j], b1[j], c1, kc); }
                    u32x2 w; w.x = pk4_fp8(s0[0], s0[1], s0[2], s0[3]); w.y = pk4_fp8(s1[0], s1[1], s1[2], s1[3]);
                    st8((unsigned char*)O + eo, w); }
                else { const f32x4 g0 = a0 * descale, g1 = a1 * descale, u0 = b0 * (descale * oscale), u1 = b1 * (descale * oscale);
                    u32x4 w; w.x = cvt_pk_bf16(silu_mul(g0[0], u0[0]), silu_mul(g0[1], u0[1])); w.y = cvt_pk_bf16(silu_mul(g0[2], u0[2]), silu_mul(g0[3], u0[3]));
                    w.z = cvt_pk_bf16(silu_mul(g1[0], u1[0]), silu_mul(g1[1], u1[1])); w.w = cvt_pk_bf16(silu_mul(g1[2], u1[2]), silu_mul(g1[3], u1[3]));
                    st16((bf16_t*)O + eo, w); } }
    }
};
typedef EpiSwiGLU8T<true> EpiSwiGLU8;
struct EpiResid {
    static constexpr bool PERM = false;
    const float* base; float* out; const float* gate; float scale;
    __device__ __forceinline__ void operator()(const f32x4 (&acc)[2][2][4][2], const Unit& u, int wr, int wc, int fr, int fq) const {
        const int row0 = u.pm * BM + wr * 64 + fr, col0 = u.pn * BM + wc * 32 + 4 * fq;
        const float* gp = gate + (size_t)(u.pm >> 3) * MODW + col0;
        f32x4 gv[2][2];
#pragma unroll
        for (int bj = 0; bj < 2; ++bj)
#pragma unroll
            for (int n = 0; n < 2; ++n) gv[bj][n] = *(const f32x4*)(gp + bj * HALF + n * 16) * scale;
#pragma unroll
        for (int ai = 0; ai < 2; ++ai)
#pragma unroll
            for (int m = 0; m < 4; ++m) { const size_t off = (size_t)(row0 + ai * HALF + m * 16) * DM + col0;
#pragma unroll
                for (int bj = 0; bj < 2; ++bj)
#pragma unroll
                    for (int n = 0; n < 2; ++n) { const f32x4 x = *(const f32x4*)(base + off + bj * HALF + n * 16); st16f(out + off + bj * HALF + n * 16, x + gv[bj][n] * acc[ai][bj][m][n]); } }
    }
};

struct EpiInProj {
    static constexpr bool PERM = true;
    bf16_t* O;
    __device__ __forceinline__ void operator()(const f32x4 (&acc)[2][2][4][2], const Unit& u, int wr, int wc, int fr, int fq) const {
        const int row0 = u.pm * BM + wr * 64 + fr, lc = wc * 32 + 8 * fq;
        if (u.pn >= 6 && u.pn < 14) {
            const int col0 = OFF_U + (u.pn - 6) * HALF + lc;
#pragma unroll
            for (int ai = 0; ai < 2; ++ai)
#pragma unroll
                for (int m = 0; m < 4; ++m) { const f32x4 v0 = acc[ai][0][m][0] * acc[ai][1][m][0], v1 = acc[ai][0][m][1] * acc[ai][1][m][1];
                    u32x4 w; w.x = cvt_pk_bf16(v0[0], v0[1]); w.y = cvt_pk_bf16(v0[2], v0[3]); w.z = cvt_pk_bf16(v1[0], v1[1]); w.w = cvt_pk_bf16(v1[2], v1[3]);
                    *(u32x4*)(O + (size_t)(row0 + ai * HALF + m * 16) * PW + col0) = w; }
        } else {
            const int col0 = (u.pn < 6 ? u.pn * BM : 2560 + (u.pn - 14) * BM) + lc;
#pragma unroll
            for (int ai = 0; ai < 2; ++ai)
#pragma unroll
                for (int m = 0; m < 4; ++m) { bf16_t* rowp = O + (size_t)(row0 + ai * HALF + m * 16) * PW + col0;
#pragma unroll
                    for (int bj = 0; bj < 2; ++bj) { const f32x4 v0 = acc[ai][bj][m][0], v1 = acc[ai][bj][m][1];
                        u32x4 w; w.x = cvt_pk_bf16(v0[0], v0[1]); w.y = cvt_pk_bf16(v0[2], v0[3]); w.z = cvt_pk_bf16(v1[0], v1[1]); w.w = cvt_pk_bf16(v1[2], v1[3]);
                        *(u32x4*)(rowp + bj * HALF) = w; } }
        }
    }
};
struct EpiStoreFp8 {
    static constexpr bool PERM = true;
    unsigned char* O; int ldc; float scale;
    __device__ __forceinline__ void operator()(const f32x4 (&acc)[2][2][4][2], const Unit& u, int wr, int wc, int fr, int fq) const {
        const int row0 = u.pm * BM + wr * 64 + fr, col0 = u.pn * BM + wc * 32 + 8 * fq;
#pragma unroll
        for (int ai = 0; ai < 2; ++ai)
#pragma unroll
            for (int m = 0; m < 4; ++m) { unsigned char* rowp = O + (size_t)(row0 + ai * HALF + m * 16) * ldc + col0;
#pragma unroll
                for (int bj = 0; bj < 2; ++bj) { const f32x4 v0 = acc[ai][bj][m][0] * scale, v1 = acc[ai][bj][m][1] * scale;
                    u32x2 w; w.x = pk4_fp8(v0[0], v0[1], v0[2], v0[3]); w.y = pk4_fp8(v1[0], v1[1], v1[2], v1[3]);
                    *(u32x2*)(rowp + bj * HALF) = w; } }
    }
};
template <bool BASE_F32> struct EpiResidBf {
    static constexpr bool PERM = true;
    const void* base; bf16_t* out; const float* gate; float scale;
    __device__ __forceinline__ void operator()(const f32x4 (&acc)[2][2][4][2], const Unit& u, int wr, int wc, int fr, int fq) const {
        const int row0 = u.pm * BM + wr * 64 + fr, col0 = u.pn * BM + wc * 32 + 8 * fq;
        const float* gp = gate + (size_t)(u.pm >> 3) * MODW + col0;
        f32x4 gv[2][2];
#pragma unroll
        for (int bj = 0; bj < 2; ++bj)
#pragma unroll
            for (int n = 0; n < 2; ++n) gv[bj][n] = *(const f32x4*)(gp + bj * HALF + n * 4) * scale;
#pragma unroll
        for (int ai = 0; ai < 2; ++ai)
#pragma unroll
            for (int m = 0; m < 4; ++m) { const size_t off = (size_t)(row0 + ai * HALF + m * 16) * DM + col0;
#pragma unroll
                for (int bj = 0; bj < 2; ++bj) { f32x4 x0, x1;
                    if (BASE_F32) { x0 = *(const f32x4*)((const float*)base + off + bj * HALF); x1 = *(const f32x4*)((const float*)base + off + bj * HALF + 4); }
                    else { const u32x4 w = *(const u32x4*)((const bf16_t*)base + off + bj * HALF); x0 = (f32x4){bf_lo(w.x), bf_hi(w.x), bf_lo(w.y), bf_hi(w.y)}; x1 = (f32x4){bf_lo(w.z), bf_hi(w.z), bf_lo(w.w), bf_hi(w.w)}; }
                    const f32x4 y0 = x0 + gv[bj][0] * acc[ai][bj][m][0], y1 = x1 + gv[bj][1] * acc[ai][bj][m][1];
                    u32x4 o; o.x = cvt_pk_bf16(y0[0], y0[1]); o.y = cvt_pk_bf16(y0[2], y0[3]); o.z = cvt_pk_bf16(y1[0], y1[1]); o.w = cvt_pk_bf16(y1[2], y1[3]);
                    *(u32x4*)(out + off + bj * HALF) = o; } }
    }
};

template <bool BASE_F32, bool OUT8> struct EpiResidNorm {
    static constexpr bool PERM = true;
    const void* base; bf16_t* out; const float* gate; float scale;
    const float* gn; const float* mod; int ish, isc;
    void* H; float* xbuf; unsigned* cnt; unsigned* tmo; LAS unsigned char* tb;
    __device__ __forceinline__ void operator()(f32x4 (&acc)[2][2][4][2], const Unit& u, int wr, int wc, int fr, int fq) const {
        const int lane = fq * 16 + fr, wid = wr * 4 + wc;
        LAS float* P = (LAS float*)tb; LAS float* S = P + 1024; LAS unsigned* flag = (LAS unsigned*)(S + 256);
        const int row0 = u.pm * BM + wr * 64 + fr, col0 = u.pn * BM + wc * 32 + 8 * fq; const int b = u.pm >> 3;
        int pbase = (wr * 64 + fr) * 4 + wc, sbase = wr * 64 + fr;
        asm volatile("" : "+v"(pbase), "+v"(sbase));
        {
            const float* gp = gate + (size_t)b * MODW + col0;
            f32x4 gv[2][2];
#pragma unroll
            for (int bj = 0; bj < 2; ++bj)
#pragma unroll
                for (int n = 0; n < 2; ++n) gv[bj][n] = *(const f32x4*)(gp + bj * HALF + n * 4) * scale;
#pragma unroll
            for (int ai = 0; ai < 2; ++ai)
#pragma unroll
                for (int m = 0; m < 4; ++m) { const size_t off = (size_t)(row0 + ai * HALF + m * 16) * DM + col0; float ss = 0.f;
#pragma unroll
                    for (int bj = 0; bj < 2; ++bj) { f32x4 x0, x1;
                        if (BASE_F32) { x0 = *(const f32x4*)((const float*)base + off + bj * HALF); x1 = *(const f32x4*)((const float*)base + off + bj * HALF + 4); }
                        else { const u32x4 w = *(const u32x4*)((const bf16_t*)base + off + bj * HALF); x0 = (f32x4){bf_lo(w.x), bf_hi(w.x), bf_lo(w.y), bf_hi(w.y)}; x1 = (f32x4){bf_lo(w.z), bf_hi(w.z), bf_lo(w.w), bf_hi(w.w)}; }
                        const f32x4 y0 = x0 + gv[bj][0] * acc[ai][bj][m][0], y1 = x1 + gv[bj][1] * acc[ai][bj][m][1];
                        acc[ai][bj][m][0] = y0; acc[ai][bj][m][1] = y1;
                        ss += ((y0[0] * y0[0] + y0[1] * y0[1]) + (y0[2] * y0[2] + y0[3] * y0[3])) + ((y1[0] * y1[0] + y1[1] * y1[1]) + (y1[2] * y1[2] + y1[3] * y1[3])); }
                    ss += swz_xor<16>(ss);
                    { auto rr = __builtin_amdgcn_permlane32_swap(__float_as_uint(ss), __float_as_uint(ss), false, false); ss = __uint_as_float(rr[0]) + __uint_as_float(rr[1]); }
                    if (fq == 0) P[pbase + (ai * HALF + m * 16) * 4] = ss; }
        }
        asm volatile("s_waitcnt lgkmcnt(0)" ::: "memory"); __builtin_amdgcn_s_barrier(); asm volatile("" ::: "memory");
        int row = wid * 32 + (lane & 31);
        asm volatile("" : "+v"(row));
        if (lane < 32) { const f32x4 p = *(const LAS f32x4*)(P + row * 4);
            __hip_atomic_store(xbuf + ((size_t)u.pm * BM + row) * 8 + u.pn, (p[0] + p[1]) + (p[2] + p[3]), __ATOMIC_RELAXED, __HIP_MEMORY_SCOPE_AGENT); }
        asm volatile("s_waitcnt vmcnt(0)" ::: "memory");
        if (lane == 0) (void)__hip_atomic_fetch_add(cnt + 64 * u.pm, 1u, __ATOMIC_RELAXED, __HIP_MEMORY_SCOPE_AGENT);
#pragma unroll
        for (int ai = 0; ai < 2; ++ai)
#pragma unroll
            for (int m = 0; m < 4; ++m) { const size_t off = (size_t)(row0 + ai * HALF + m * 16) * DM + col0;
#pragma unroll
                for (int bj = 0; bj < 2; ++bj) { const f32x4 y0 = acc[ai][bj][m][0], y1 = acc[ai][bj][m][1];
                    u32x4 o; o.x = cvt_pk_bf16(y0[0], y0[1]); o.y = cvt_pk_bf16(y0[2], y0[3]); o.z = cvt_pk_bf16(y1[0], y1[1]); o.w = cvt_pk_bf16(y1[2], y1[3]);
                    *(u32x4*)(out + off + bj * HALF) = o; } }
        if (wid == 0) { unsigned sp = 0u, dead = 0u;
            while ((unsigned)__builtin_amdgcn_readfirstlane((int)__hip_atomic_load(cnt + 64 * u.pm, __ATOMIC_RELAXED, __HIP_MEMORY_SCOPE_AGENT)) < 64u) {
                __builtin_amdgcn_s_sleep(1);
                if ((++sp & 255u) == 0u) { if (__hip_atomic_load(tmo, __ATOMIC_RELAXED, __HIP_MEMORY_SCOPE_AGENT)) { dead = 1u; break; } if (sp > (1u << 18)) { if (lane == 0) atomicAdd(tmo, 1u); dead = 1u; break; } } }
            __builtin_amdgcn_fence(__ATOMIC_ACQUIRE, "agent");
            if (lane == 0) flag[0] = dead; }
        asm volatile("s_waitcnt vmcnt(0) lgkmcnt(0)" ::: "memory"); __builtin_amdgcn_s_barrier(); asm volatile("" ::: "memory");
        if (lane < 32) { const float* sl = xbuf + ((size_t)u.pm * BM + row) * 8; float t = 0.f;
#pragma unroll
            for (int k = 0; k < 8; ++k) t += __hip_atomic_load(sl + k, __ATOMIC_RELAXED, __HIP_MEMORY_SCOPE_AGENT);
            S[row] = rsqrtf(t * (1.0f / DM) + EPS); }
        asm volatile("s_waitcnt vmcnt(0) lgkmcnt(0)" ::: "memory"); __builtin_amdgcn_s_barrier(); asm volatile("" ::: "memory");
        const float* mp = mod + (size_t)b * MODW;
#pragma unroll
        for (int bj = 0; bj < 2; ++bj) {
            f32x4 Am[2], Bm[2];
#pragma unroll
            for (int n = 0; n < 2; ++n) { const int c = col0 + bj * HALF + n * 4;
                Am[n] = *(const f32x4*)(gn + c) * (*(const f32x4*)(mp + isc + c) + 1.0f) * (OUT8 ? FP8_ASCALE : 1.0f); Bm[n] = *(const f32x4*)(mp + ish + c) * (OUT8 ? FP8_ASCALE : 1.0f); }
#pragma unroll
            for (int ai = 0; ai < 2; ++ai)
#pragma unroll
                for (int m = 0; m < 4; ++m) { const int r = ai * HALF + wr * 64 + m * 16 + fr; const float rs = S[sbase + ai * HALF + m * 16]; const size_t off = (size_t)(u.pm * BM + r) * DM + col0 + bj * HALF;
                    const f32x4 h0 = acc[ai][bj][m][0] * rs * Am[0] + Bm[0], h1 = acc[ai][bj][m][1] * rs * Am[1] + Bm[1];
                    if (OUT8) { u32x2 w; w.x = pk4_fp8(h0[0], h0[1], h0[2], h0[3]); w.y = pk4_fp8(h1[0], h1[1], h1[2], h1[3]); *(u32x2*)((unsigned char*)H + off) = w; }
                    else { u32x4 w; w.x = cvt_pk_bf16(h0[0], h0[1]); w.y = cvt_pk_bf16(h0[2], h0[3]); w.z = cvt_pk_bf16(h1[0], h1[1]); w.w = cvt_pk_bf16(h1[2], h1[3]); *(u32x4*)((bf16_t*)H + off) = w; } }
            asm volatile("" ::: "memory"); }
    }
};

template <class Epi, class Sched, bool ALIGN_EPI, bool SP2, bool GATHER, int VAR = 0, bool FP8 = false>
__device__ __forceinline__ void gemm_phase(LAS unsigned char* lds, const Gemm g, const Sched& S, const Epi& E, int g_wave) {
    const int tid = opaque_tid(), wid = __builtin_amdgcn_readfirstlane(tid >> 6), lane = tid & 63, wr = wid >> 2, wc = wid & 3, fr = lane & 15, fq = lane >> 4;
    const int KB = g.KB, nt = KB / (BK * 2);
    int Rr[2], Cc[2];
    unsigned voffB[2];
#pragma unroll
    for (int i = 0; i < 2; ++i) { stage_rc(tid * 16 + i * 8192, Rr[i], Cc[i]); const int Rb = Epi::PERM ? ((Rr[i] & ~31) + perm32(Rr[i] & 31)) : Rr[i]; voffB[i] = (unsigned)(Rb * KB + Cc[i] * 2); }
    const size_t kstep = (size_t)(BK * 2);
    const size_t hstep = (size_t)HALF * KB;
    const size_t tstep = 2 * hstep;
    const unsigned ldsw = (unsigned)wid * 1024u;
    const int aoff = lds_byte(wr * 64 + fr, fq * 8), boff = lds_byte(wc * 32 + fr, fq * 8);
#define PG8_SA(b, h) (((b) * 2 + (h)) * HTB)
#define PG8_SB(b, h) ((4 + (b) * 2 + (h)) * HTB)
#define PG8_STAGE(bufoff, gbase, voff) do { if constexpr (VAR != 3) _Pragma("unroll") for (int _i = 0; _i < 2; ++_i) \
        __builtin_amdgcn_global_load_lds((const unsigned*)((const char*)(gbase) + (voff)[_i]), (LAS unsigned*)(lds + (bufoff) + ldsw + _i * 8192), 16, 0, 0); } while (0)
#define PG8_LDA(dst, b, h) do { if constexpr (FP8) { _Pragma("unroll") for (int m = 0; m < 4; ++m) dst##8[m] = PG8_CAT8(*(const LAS v4i*)(lds + PG8_SA(b, h) + aoff + m * 2048), *(const LAS v4i*)(lds + PG8_SA(b, h) + aoff + m * 2048 + 1024)); } \
    else { _Pragma("unroll") for (int m = 0; m < 4; ++m) _Pragma("unroll") for (int k = 0; k < 2; ++k) dst[m][k] = *(const LAS bf16x8*)(lds + PG8_SA(b, h) + aoff + m * 2048 + k * 1024); } } while (0)
#define PG8_LDB(dst, b, h) do { if constexpr (FP8) { _Pragma("unroll") for (int n = 0; n < 2; ++n) dst##8[n] = PG8_CAT8(*(const LAS v4i*)(lds + PG8_SB(b, h) + boff + n * 2048), *(const LAS v4i*)(lds + PG8_SB(b, h) + boff + n * 2048 + 1024)); } \
    else { _Pragma("unroll") for (int n = 0; n < 2; ++n) _Pragma("unroll") for (int k = 0; k < 2; ++k) dst[n][k] = *(const LAS bf16x8*)(lds + PG8_SB(b, h) + boff + n * 2048 + k * 1024); } } while (0)
#define PG8_X4(v16, m) ((m) == 0 ? __builtin_shufflevector(v16, v16, 0, 1, 2, 3) : (m) == 1 ? __builtin_shufflevector(v16, v16, 4, 5, 6, 7) : (m) == 2 ? __builtin_shufflevector(v16, v16, 8, 9, 10, 11) : __builtin_shufflevector(v16, v16, 12, 13, 14, 15))
#define PG8_W16(c) __builtin_shufflevector(c, c, 0, 1, 2, 3, -1, -1, -1, -1, -1, -1, -1, -1, -1, -1, -1, -1)
#define PG8_I4(v16, c, m) ((m) == 0 ? __builtin_shufflevector(v16, PG8_W16(c), 16, 17, 18, 19, 4, 5, 6, 7, 8, 9, 10, 11, 12, 13, 14, 15) : (m) == 1 ? __builtin_shufflevector(v16, PG8_W16(c), 0, 1, 2, 3, 16, 17, 18, 19, 8, 9, 10, 11, 12, 13, 14, 15) : \
    (m) == 2 ? __builtin_shufflevector(v16, PG8_W16(c), 0, 1, 2, 3, 4, 5, 6, 7, 16, 17, 18, 19, 12, 13, 14, 15) : __builtin_shufflevector(v16, PG8_W16(c), 0, 1, 2, 3, 4, 5, 6, 7, 8, 9, 10, 11, 16, 17, 18, 19))
#define PG8_CAT8(x, y) __builtin_shufflevector(__builtin_bit_cast(v4i, x), __builtin_bit_cast(v4i, y), 0, 1, 2, 3, 4, 5, 6, 7)
#define PG8_MMA(ai, bj, At, Bt) do { if constexpr (VAR == 2) { \
        _Pragma("unroll") for (int m = 0; m < 4; ++m) _Pragma("unroll") for (int k = 0; k < 2; ++k) asm volatile("" :: "v"(At[m][k])); _Pragma("unroll") for (int n = 0; n < 2; ++n) _Pragma("unroll") for (int k = 0; k < 2; ++k) asm volatile("" :: "v"(Bt[n][k])); } \
    else if constexpr (FP8) { __builtin_amdgcn_s_setprio(1); _Pragma("unroll") for (int m = 0; m < 4; ++m) _Pragma("unroll") for (int n = 0; n < 2; ++n) \
        { f32x4 c_ = PG8_X4(acc16[ai][bj][n], m); c_ = __builtin_amdgcn_mfma_scale_f32_16x16x128_f8f6f4(Bt##8[n], At##8[m], c_, 0, 0, 0, 0, 0, 0); acc16[ai][bj][n] = PG8_I4(acc16[ai][bj][n], c_, m); } __builtin_amdgcn_s_setprio(0); } \
    else { __builtin_amdgcn_s_setprio(1); _Pragma("unroll") for (int m = 0; m < 4; ++m) _Pragma("unroll") for (int n = 0; n < 2; ++n) _Pragma("unroll") for (int k = 0; k < 2; ++k) \
        acc[ai][bj][m][n] = __builtin_amdgcn_mfma_f32_16x16x32_bf16(Bt[n][k], At[m][k], acc[ai][bj][m][n], 0, 0, 0); __builtin_amdgcn_s_setprio(0); } } while (0)
#define PG8_WAIT_V(n) asm volatile("s_waitcnt vmcnt(" #n ")" ::: "memory")
#define PG8_WAIT_L(n) asm volatile("s_waitcnt lgkmcnt(" #n ")" ::: "memory")
#define PG8_BAR __builtin_amdgcn_s_barrier()
#define PG8_SCHED __builtin_amdgcn_sched_barrier(0)
    Unit cur, nxt; int ui = 0;
    if (!S.next(0, cur)) return;
    f32x4 acc[2][2][4][2];
    f32x16 acc16[2][2][2];
#pragma unroll
    for (int a = 0; a < 2; ++a)
#pragma unroll
        for (int b = 0; b < 2; ++b)
#pragma unroll
            for (int n = 0; n < 2; ++n) acc16[a][b][n] = f32x16{};
#pragma unroll
    for (int a = 0; a < 2; ++a)
#pragma unroll
        for (int b = 0; b < 2; ++b)
#pragma unroll
            for (int m = 0; m < 4; ++m)
#pragma unroll
                for (int n = 0; n < 2; ++n) acc[a][b][m][n] = (f32x4){0.f, 0.f, 0.f, 0.f};
    bf16x8 At[4][2], B0[2][2], B1[2][2];
    v8i At8[4], B08[2], B18[2];
    unsigned vc0[2], vc1[2], vn0[2], vn1[2];
    const int hA = GATHER ? 0 : (int)hstep, hB = (int)hstep;
    const char* cA; const char* cB = (const char*)g.Bt + (size_t)cur.pb * tstep;
    if constexpr (GATHER) {
        cA = (const char*)g.A;
#pragma unroll
        for (int i = 0; i < 2; ++i) { vc0[i] = (unsigned)(S.arow(cur, Rr[i]) * KB + Cc[i] * 2); vc1[i] = (unsigned)(S.arow(cur, HALF + Rr[i]) * KB + Cc[i] * 2); vn0[i] = vc0[i]; vn1[i] = vc1[i]; }
        asm volatile("" : "+v"(vc0[0]), "+v"(vc0[1]), "+v"(vc1[0]), "+v"(vc1[1]));
    } else {
        cA = (const char*)g.A + (size_t)cur.pm * tstep;
#pragma unroll
        for (int i = 0; i < 2; ++i) { vc0[i] = (unsigned)(Rr[i] * KB + Cc[i] * 2); vc1[i] = vc0[i]; vn0[i] = vc0[i]; vn1[i] = vc0[i]; }
    }
#undef PG8_STAGE
#define PG8_STAGE(bufoff, gbase, soff, voff) do { if constexpr (VAR != 3) { const __amdgpu_buffer_rsrc_t rs_ = __builtin_amdgcn_make_buffer_rsrc((void*)(gbase), 0, 0x7fffffff, 0x00020000); \
        _Pragma("unroll") for (int _i = 0; _i < 2; ++_i) __builtin_amdgcn_raw_ptr_buffer_load_lds(rs_, (LAS void*)(lds + (bufoff) + ldsw + _i * 8192), 16, (int)(voff)[_i], (int)(soff), 0, 0); } } while (0)
    constexpr int KS = BK * 2;
    if constexpr (SP2) {
        PG8_STAGE(PG8_SB(0, 0), cB, 0, voffB); PG8_STAGE(PG8_SB(0, 1), cB, hB, voffB); PG8_STAGE(PG8_SA(0, 0), cA, 0, vc0); PG8_STAGE(PG8_SA(0, 1), cA, hA, vc1);
        PG8_STAGE(PG8_SB(1, 0), cB, KS, voffB); PG8_STAGE(PG8_SA(1, 0), cA, KS, vc0); PG8_STAGE(PG8_SB(1, 1), cB, hB + KS, voffB);
        if (wr == 1) PG8_BAR;
        PG8_WAIT_V(8); PG8_BAR;
        PG8_WAIT_V(6); PG8_BAR;
    } else {
        PG8_STAGE(PG8_SB(0, 0), cB, 0, voffB); PG8_STAGE(PG8_SA(0, 0), cA, 0, vc0); PG8_STAGE(PG8_SB(0, 1), cB, hB, voffB); PG8_STAGE(PG8_SA(0, 1), cA, hA, vc1);
        if (wr == 1) PG8_BAR;
        PG8_WAIT_V(4); PG8_BAR;
        PG8_STAGE(PG8_SB(1, 0), cB, KS, voffB); PG8_STAGE(PG8_SA(1, 0), cA, KS, vc0); PG8_STAGE(PG8_SB(1, 1), cB, hB + KS, voffB);
        PG8_WAIT_V(6); PG8_BAR;
    }
    for (;;) {
        const bool has_next = S.next(ui + 1, nxt);
        const char* nA; const char* nB = has_next ? (const char*)g.Bt + (size_t)nxt.pb * tstep : cB;
        if constexpr (GATHER) {
            nA = cA;
            if (has_next && nxt.pm != cur.pm) {
                const int tid2 = opaque_tid();
#pragma unroll
                for (int i = 0; i < 2; ++i) { int R2, C2; stage_rc(tid2 * 16 + i * 8192, R2, C2); vn0[i] = (unsigned)(S.arow(nxt, R2) * KB + C2 * 2); vn1[i] = (unsigned)(S.arow(nxt, HALF + R2) * KB + C2 * 2); }
                asm volatile("" : "+v"(vn0[0]), "+v"(vn0[1]), "+v"(vn1[0]), "+v"(vn1[1]));
            }
        } else {
            nA = has_next ? (const char*)g.A + (size_t)nxt.pm * tstep : cA;
        }
        for (int t = 0; t < nt; t += 2) {
            const bool last = (t == nt - 2);
            const int k1 = (t + 1) * KS;
            const char* a2 = last ? nA : cA; const char* b2 = last ? nB : cB;
            const int k2 = last ? 0 : (t + 2) * KS, k3 = k2 + KS;
            unsigned w0[2], w1[2];
            if constexpr (GATHER) {
#pragma unroll
                for (int i = 0; i < 2; ++i) { w0[i] = last ? vn0[i] : vc0[i]; w1[i] = last ? vn1[i] : vc1[i]; }
            } else {
#pragma unroll
                for (int i = 0; i < 2; ++i) { w0[i] = vc0[i]; w1[i] = vc0[i]; }
            }
            if constexpr (SP2) {
            PG8_LDB(B0, 0, 0); PG8_LDB(B1, 0, 1); PG8_SCHED; PG8_LDA(At, 0, 0); PG8_STAGE(PG8_SA(1, 1), cA, k1 + hA, vc1);
            PG8_WAIT_V(8); PG8_WAIT_L(0); PG8_BAR; PG8_MMA(0, 0, At, B0); PG8_MMA(0, 1, At, B1); PG8_BAR; PG8_SCHED;
            PG8_LDA(At, 0, 1); PG8_STAGE(PG8_SB(0, 0), b2, k2, voffB); PG8_STAGE(PG8_SB(0, 1), b2, k2 + hB, voffB); PG8_STAGE(PG8_SA(0, 0), a2, k2, w0);
            PG8_WAIT_V(8); PG8_WAIT_L(0); PG8_BAR; PG8_MMA(1, 0, At, B0); PG8_MMA(1, 1, At, B1); PG8_BAR; PG8_SCHED;
            PG8_LDB(B0, 1, 0); PG8_LDB(B1, 1, 1); PG8_SCHED; PG8_LDA(At, 1, 0); PG8_STAGE(PG8_SA(0, 1), a2, k2 + hA, w1);
            PG8_WAIT_V(8); PG8_WAIT_L(0); PG8_BAR; PG8_MMA(0, 0, At, B0); PG8_MMA(0, 1, At, B1); PG8_BAR; PG8_SCHED;
            PG8_LDA(At, 1, 1); PG8_STAGE(PG8_SB(1, 0), b2, k3, voffB); PG8_STAGE(PG8_SB(1, 1), b2, k3 + hB, voffB); PG8_STAGE(PG8_SA(1, 0), a2, k3, w0);
            PG8_WAIT_V(8); PG8_WAIT_L(0); PG8_BAR; PG8_MMA(1, 0, At, B0); PG8_MMA(1, 1, At, B1); PG8_BAR; PG8_SCHED;
            } else {
            PG8_LDB(B0, 0, 0); PG8_SCHED; PG8_LDA(At, 0, 0); PG8_STAGE(PG8_SA(1, 1), cA, k1 + hA, vc1);
            PG8_WAIT_L(8); PG8_BAR; PG8_WAIT_L(0); PG8_MMA(0, 0, At, B0); PG8_BAR; PG8_SCHED;
            PG8_LDB(B1, 0, 1); PG8_STAGE(PG8_SB(0, 0), b2, k2, voffB);
            PG8_BAR; PG8_WAIT_L(0); PG8_MMA(0, 1, At, B1); PG8_BAR;
            PG8_LDA(At, 0, 1); PG8_STAGE(PG8_SA(0, 0), a2, k2, w0);
            PG8_BAR; PG8_WAIT_L(0); PG8_MMA(1, 0, At, B0); PG8_BAR; PG8_SCHED;
            PG8_STAGE(PG8_SB(0, 1), b2, k2 + hB, voffB);
            PG8_WAIT_V(6); PG8_BAR; PG8_MMA(1, 1, At, B1); PG8_BAR;
            PG8_LDB(B0, 1, 0); PG8_SCHED; PG8_LDA(At, 1, 0); PG8_STAGE(PG8_SA(0, 1), a2, k2 + hA, w1);
            PG8_WAIT_L(8); PG8_BAR; PG8_WAIT_L(0); PG8_MMA(0, 0, At, B0); PG8_BAR; PG8_SCHED;
            PG8_LDB(B1, 1, 1); PG8_STAGE(PG8_SB(1, 0), b2, k3, voffB);
            PG8_BAR; PG8_WAIT_L(0); PG8_MMA(0, 1, At, B1); PG8_BAR;
            PG8_LDA(At, 1, 1); PG8_STAGE(PG8_SA(1, 0), a2, k3, w0);
            PG8_BAR; PG8_WAIT_L(0); PG8_MMA(1, 0, At, B0); PG8_BAR; PG8_SCHED;
            PG8_STAGE(PG8_SB(1, 1), b2, k3 + hB, voffB);
            PG8_WAIT_V(6); PG8_BAR; PG8_MMA(1, 1, At, B1); PG8_BAR;
            }
        }
        if constexpr (ALIGN_EPI) { if (wr == 0) PG8_BAR; }
        if constexpr (FP8) {
#pragma unroll
            for (int a = 0; a < 2; ++a)
#pragma unroll
                for (int b = 0; b < 2; ++b)
#pragma unroll
                    for (int n = 0; n < 2; ++n) { acc[a][b][0][n] = PG8_X4(acc16[a][b][n], 0); acc[a][b][1][n] = PG8_X4(acc16[a][b][n], 1); acc[a][b][2][n] = PG8_X4(acc16[a][b][n], 2); acc[a][b][3][n] = PG8_X4(acc16[a][b][n], 3); acc16[a][b][n] = f32x16{}; }
        }
        if constexpr (VAR == 0) E(acc, cur, wr, wc, fr, fq); else { _Pragma("unroll") for (int a_ = 0; a_ < 2; ++a_) _Pragma("unroll") for (int b_ = 0; b_ < 2; ++b_) _Pragma("unroll") for (int m_ = 0; m_ < 4; ++m_) _Pragma("unroll") for (int n_ = 0; n_ < 2; ++n_) asm volatile("" :: "v"(acc[a_][b_][m_][n_])); }
        if (!has_next) break;
#pragma unroll
        for (int a = 0; a < 2; ++a)
#pragma unroll
            for (int b = 0; b < 2; ++b)
#pragma unroll
                for (int m = 0; m < 4; ++m)
#pragma unroll
                    for (int n = 0; n < 2; ++n) acc[a][b][m][n] = (f32x4){0.f, 0.f, 0.f, 0.f};
        cur = nxt; cA = nA; cB = nB; ++ui;
        if constexpr (GATHER) {
#pragma unroll
            for (int i = 0; i < 2; ++i) { vc0[i] = vn0[i]; vc1[i] = vn1[i]; } }
        if constexpr (ALIGN_EPI) { if (wr == 1) PG8_BAR; }
    }
    PG8_WAIT_V(0);
    if constexpr (!ALIGN_EPI) { if (wr == 0) PG8_BAR; }
    PG8_BAR;
#undef PG8_SA
#undef PG8_SB
#undef PG8_STAGE
#undef PG8_LDA
#undef PG8_LDB
#undef PG8_MMA
#undef PG8_CAT8
#undef PG8_X4
#undef PG8_W16
#undef PG8_I4
#undef PG8_WAIT_V
#undef PG8_WAIT_L
#undef PG8_BAR
#undef PG8_SCHED
}
}

namespace attn {
constexpr int D = 128, NW = 8, QBLK = 32, KVBLK = 64;
constexpr float SCALE = 0.088388347648318440f;
constexpr float THR = 8.f;
constexpr int LDQ = 1024, LDKV = 512, LDO = DM;
constexpr size_t SHM_V = KVBLK * D * 2, SHM_K = KVBLK * D * 2, SHM_ATTN = 2 * SHM_V + 2 * SHM_K + NW * 64 * 4;
#define KSWZ(row, colB) ((row) * 256 + ((colB) ^ (((row) & 7) << 4)))
#define SBAR() __builtin_amdgcn_sched_barrier(0)
__device__ __forceinline__ int crow(int r, int hi) { return (r & 3) + 8 * (r >> 2) + 4 * hi; }
__device__ __forceinline__ void partialSM(f32x16& p0, f32x16& p1, float& m_reg, float& mn, float& alpha) {
  constexpr float C = SCALE * 1.4426950408889634f;
  float pmax = p0[0]; for (int r = 1; r < 16; ++r) pmax = fmaxf(pmax, p0[r]); for (int r = 0; r < 16; ++r) pmax = fmaxf(pmax, p1[r]);
  { auto rr = __builtin_amdgcn_permlane32_swap(__float_as_uint(pmax), __float_as_uint(pmax), false, false);
    pmax = fmaxf(__uint_as_float(rr[0]), __uint_as_float(rr[1])); }
  if (__builtin_expect(__all(pmax - m_reg <= THR / SCALE), 1)) { mn = m_reg; alpha = 1.f; }
  else { mn = fmaxf(m_reg, pmax); alpha = __builtin_amdgcn_exp2f((m_reg - mn) * C); m_reg = mn; }
  float mnC = -mn * C;
  for (int r = 0; r < 16; ++r) p0[r] = fmaf(p0[r], C, mnC); for (int r = 0; r < 16; ++r) p1[r] = fmaf(p1[r], C, mnC);
  for (int r = 0; r < 16; ++r) p0[r] = __builtin_amdgcn_exp2f(p0[r]);
}
__device__ __forceinline__ void finishSM(f32x16& p0, f32x16& p1, float alpha, float& l_reg, bf16x8& pa0, bf16x8& pa1, bf16x8& pa2, bf16x8& pa3) {
  for (int r = 0; r < 16; ++r) p1[r] = __builtin_amdgcn_exp2f(p1[r]);
  float ps = 0; for (int r = 0; r < 16; ++r) ps += p0[r]; for (int r = 0; r < 16; ++r) ps += p1[r];
  { auto rr = __builtin_amdgcn_permlane32_swap(__float_as_uint(ps), __float_as_uint(ps), false, false);
    ps = __uint_as_float(rr[0]) + __uint_as_float(rr[1]); }
  l_reg = l_reg * alpha + ps;
#define PK4(P, BASE, OUT) do { unsigned a0 = cvt_pk_bf16(P[BASE + 0], P[BASE + 1]), a1 = cvt_pk_bf16(P[BASE + 2], P[BASE + 3]);   \
    unsigned b0 = cvt_pk_bf16(P[BASE + 4], P[BASE + 5]), b1 = cvt_pk_bf16(P[BASE + 6], P[BASE + 7]);                              \
    auto r0 = __builtin_amdgcn_permlane32_swap(a0, b0, false, false); auto r1 = __builtin_amdgcn_permlane32_swap(a1, b1, false, false); \
    u32x4 w = {r0[0], r1[0], r0[1], r1[1]}; OUT = *reinterpret_cast<bf16x8*>(&w); } while (0)
  PK4(p0, 0, pa0); PK4(p0, 8, pa1); PK4(p1, 0, pa2); PK4(p1, 8, pa3);
#undef PK4
}
__device__ __forceinline__ void qkt(f32x16& p0, f32x16& p1, const bf16_t* Ks, const bf16x8* qr, int r32, int hi) {
  p0 = f32x16{}; p1 = f32x16{};
  for (int d0 = 0; d0 < 8; ++d0) { int cb = (d0 * 16 + hi * 8) * 2;
    bf16x8 b0 = *reinterpret_cast<const bf16x8*>((const char*)Ks + KSWZ(r32, cb));
    bf16x8 b1 = *reinterpret_cast<const bf16x8*>((const char*)Ks + KSWZ(32 + r32, cb));
    p0 = __builtin_amdgcn_mfma_f32_32x32x16_bf16(b0, qr[d0], p0, 0, 0, 0);
    p1 = __builtin_amdgcn_mfma_f32_32x32x16_bf16(b1, qr[d0], p1, 0, 0, 0); }
}
__device__ __forceinline__ int v_st(int k, int c) { const int kk = (k & ~0xC) | ((k & 4) << 1) | ((k & 8) >> 1); return ((kk >> 3) * 4 + (c >> 5)) * 512 + ((kk & 7) * 32 + (c & 31)) * 2; }
__device__ __forceinline__ int v_rd_base(int lane) { return ((lane & 3) << 3) | (((lane >> 2) & 3) << 6) | (((lane >> 4) & 1) << 5) | (((lane >> 5) & 1) << 8); }
constexpr int v_rd_off(int d0, int ks, int half) { return d0 * 512 + ks * 4096 + half * 2048; }
template <int OFF> __device__ __forceinline__ s16x4 tr_read(int vb) {
  s16x4 r; asm volatile("ds_read_b64_tr_b16 %0, %1 offset:%2" : "=&v"(r) : "v"(vb), "i"(OFF) : "memory"); return r;
}
template <int D0> __device__ __forceinline__ void pv_one(f32x16& od, int vb, bf16x8 pa0, bf16x8 pa1, bf16x8 pa2, bf16x8 pa3) {
  const s16x4 l0 = tr_read<v_rd_off(D0, 0, 0)>(vb), h0 = tr_read<v_rd_off(D0, 0, 1)>(vb), l1 = tr_read<v_rd_off(D0, 1, 0)>(vb), h1 = tr_read<v_rd_off(D0, 1, 1)>(vb);
  const s16x4 l2 = tr_read<v_rd_off(D0, 2, 0)>(vb), h2 = tr_read<v_rd_off(D0, 2, 1)>(vb), l3 = tr_read<v_rd_off(D0, 3, 0)>(vb), h3 = tr_read<v_rd_off(D0, 3, 1)>(vb);
  asm volatile("s_waitcnt lgkmcnt(0)" ::: "memory"); SBAR();
#define PK(L, H) (bf16x8){L[0], L[1], L[2], L[3], H[0], H[1], H[2], H[3]}
  od = __builtin_amdgcn_mfma_f32_32x32x16_bf16(pa0, PK(l0, h0), od, 0, 0, 0);
  od = __builtin_amdgcn_mfma_f32_32x32x16_bf16(pa1, PK(l1, h1), od, 0, 0, 0);
  od = __builtin_amdgcn_mfma_f32_32x32x16_bf16(pa2, PK(l2, h2), od, 0, 0, 0);
  od = __builtin_amdgcn_mfma_f32_32x32x16_bf16(pa3, PK(l3, h3), od, 0, 0, 0);
#undef PK
}
__device__ __forceinline__ void pv_d0(f32x16* o, int vb, bf16x8 pa0, bf16x8 pa1, bf16x8 pa2, bf16x8 pa3) {
  pv_one<0>(o[0], vb, pa0, pa1, pa2, pa3); pv_one<1>(o[1], vb, pa0, pa1, pa2, pa3); pv_one<2>(o[2], vb, pa0, pa1, pa2, pa3); pv_one<3>(o[3], vb, pa0, pa1, pa2, pa3);
}
__device__ __forceinline__ void attn_unit(const bf16_t* __restrict__ Qb, const bf16_t* __restrict__ Kh, const bf16_t* __restrict__ Vh,
                                          bf16_t* __restrict__ Ob, const float* __restrict__ gain, int seq, char* lds, int g_wave) {
  const int tid = opaque_tid(), wid = tid >> 6, lane = tid & 63, r32 = lane & 31, hi = lane >> 5;
  bf16_t* V_lds = (bf16_t*)lds; bf16_t* K_lds = (bf16_t*)(lds + 2 * SHM_V);
  float* ws = (float*)(lds + 2 * SHM_V + 2 * SHM_K) + wid * 64; float* li_l = ws; float* al_l = ws + 32;
  float m_reg = -1e30f, l_reg = 0; f32x16 o[4] = {}; bf16x8 qr[8];
  const bf16_t* Qw = Qb + (long)(wid * QBLK + r32) * LDQ + hi * 8;
#pragma unroll
  for (int d0 = 0; d0 < 8; ++d0) qr[d0] = *reinterpret_cast<const bf16x8*>(Qw + d0 * 16);
  const int sr = tid >> 4, sc = (tid & 15) * 8, vst0 = v_st(sr, sc), vst1 = v_st(32 + sr, sc);
  const int vb0 = (int)(uintptr_t)V_lds + v_rd_base(lane);
  struct { bf16x8 vs0, vs1, ks0, ks1; } sr_[2];
  const unsigned soff0 = (unsigned)(sr * LDKV + sc) * 2u, soff1 = soff0 + 32u * LDKV * 2u;
#define SLOAD(i, k0) do { const char* vb_ = (const char*)Vh + (size_t)(k0) * (LDKV * 2); const char* kb_ = (const char*)Kh + (size_t)(k0) * (LDKV * 2); \
    sr_[i].vs0 = *reinterpret_cast<const bf16x8*>(vb_ + soff0); sr_[i].vs1 = *reinterpret_cast<const bf16x8*>(vb_ + soff1); \
    sr_[i].ks0 = *reinterpret_cast<const bf16x8*>(kb_ + soff0); sr_[i].ks1 = *reinterpret_cast<const bf16x8*>(kb_ + soff1); } while (0)
#define SWRITE(b, i) do { *(bf16x8*)((char*)V_lds + (b) * SHM_V + vst0) = sr_[i].vs0;          \
    *(bf16x8*)((char*)V_lds + (b) * SHM_V + vst1) = sr_[i].vs1; int kc = sc * 2;               \
    *(bf16x8*)((char*)K_lds + (b) * SHM_K + KSWZ(sr, kc)) = sr_[i].ks0;                       \
    *(bf16x8*)((char*)K_lds + (b) * SHM_K + KSWZ(32 + sr, kc)) = sr_[i].ks1; } while (0)
#define SWAIT() asm volatile("s_waitcnt vmcnt(4)" ::: "memory")
#define RESC(a) do { if (__any((a) < 1.f)) { if (hi == 0) al_l[r32] = (a); asm volatile("s_waitcnt lgkmcnt(0)" ::: "memory"); \
    for (int d = 0; d < 4; ++d) for (int r = 0; r < 16; ++r) o[d][r] *= al_l[crow(r, hi)]; } } while (0)
  f32x16 pA0, pA1, pB0, pB1; float mnA, mnB, alA, alB; bf16x8 pa0, pa1, pa2, pa3; const int NT = seq / KVBLK;
  constexpr int SE = 0, SO = 1;
  SLOAD(SE, 0); SLOAD(SO, KVBLK); asm volatile("s_waitcnt vmcnt(4)" ::: "memory"); SWRITE(0, SE); __syncthreads();
  qkt(pA0, pA1, K_lds, qr, r32, hi); partialSM(pA0, pA1, m_reg, mnA, alA);
  if (2 < NT) SLOAD(SE, 2 * KVBLK);
  SWAIT(); SWRITE(1, SO); __syncthreads();
  for (int j = 1; j + 1 < NT; j += 2) {
    SBAR(); qkt(pB0, pB1, (bf16_t*)((char*)K_lds + SHM_K), qr, r32, hi);
    finishSM(pA0, pA1, alA, l_reg, pa0, pa1, pa2, pa3); SBAR();
    SLOAD(SO, (j + 2) * KVBLK); SBAR();
    pv_d0(o, vb0, pa0, pa1, pa2, pa3); partialSM(pB0, pB1, m_reg, mnB, alB);
    __syncthreads(); SWAIT(); SWRITE(0, SE);
    RESC(alB); __syncthreads();
    SBAR(); qkt(pA0, pA1, K_lds, qr, r32, hi);
    finishSM(pB0, pB1, alB, l_reg, pa0, pa1, pa2, pa3); SBAR();
    if (j + 3 < NT) SLOAD(SE, (j + 3) * KVBLK); SBAR();
    pv_d0(o, vb0 + (int)SHM_V, pa0, pa1, pa2, pa3); partialSM(pA0, pA1, m_reg, mnA, alA);
    __syncthreads(); SWAIT(); SWRITE(1, SO);
    RESC(alA); __syncthreads();
  }
  SBAR(); qkt(pB0, pB1, (bf16_t*)((char*)K_lds + SHM_K), qr, r32, hi);
  finishSM(pA0, pA1, alA, l_reg, pa0, pa1, pa2, pa3); SBAR();
  pv_d0(o, vb0, pa0, pa1, pa2, pa3); partialSM(pB0, pB1, m_reg, mnB, alB);
  __syncthreads(); RESC(alB);
  finishSM(pB0, pB1, alB, l_reg, pa0, pa1, pa2, pa3); SBAR();
  float gn[4];
#pragma unroll
  for (int d0 = 0; d0 < 4; ++d0) gn[d0] = gain[d0 * 32 + r32];
  pv_d0(o, vb0 + (int)SHM_V, pa0, pa1, pa2, pa3);
  if (hi == 0) li_l[r32] = l_reg; asm volatile("s_waitcnt lgkmcnt(0)" ::: "memory");
  char* Ow = (char*)Ob + (size_t)(wid * QBLK) * (LDO * 2);
  const unsigned ooff = (unsigned)(4 * hi * LDO + r32) * 2u;
#pragma unroll
  for (int r = 0; r < 16; ++r) { const int orow = crow(r, hi); const float rli = __builtin_amdgcn_rcpf(li_l[orow]);
    float v0 = o[0][r] * rli, v1 = o[1][r] * rli, v2 = o[2][r] * rli, v3 = o[3][r] * rli;
    float ss = v0 * v0 + v1 * v1 + v2 * v2 + v3 * v3;
    ss = half_sum(ss);
    const float rs = rsqrtf(ss * (1.0f / 128.0f) + EPS);
    const unsigned w01 = cvt_pk_bf16(v0 * rs * gn[0], v1 * rs * gn[1]), w23 = cvt_pk_bf16(v2 * rs * gn[2], v3 * rs * gn[3]);
    char* op = Ow + (size_t)((r & 3) + 8 * (r >> 2)) * (LDO * 2);
    *(bf16_t*)(op + ooff) = (bf16_t)(w01 & 0xffffu); *(bf16_t*)(op + ooff + 64) = (bf16_t)(w01 >> 16);
    *(bf16_t*)(op + ooff + 128) = (bf16_t)(w23 & 0xffffu); *(bf16_t*)(op + ooff + 192) = (bf16_t)(w23 >> 16); }
#undef SLOAD
#undef SWRITE
#undef SWAIT
#undef RESC
}
}

#define XB_TMO      128
#define XB_XCNT(j)  (256  + 64 * (j))
#define XB_XSUB(j)  (1280 + 64 * (j))
#define XB_XGEN(j)  (2304 + 64 * (j))
#define XB_TOP      3328
#define XB_TOPGEN   3392
#define XCD_BAR_WORDS 3456
#define XB_SPIN_CAP (1u << 18)
__device__ __forceinline__ unsigned xb_ld(unsigned* p)              { return __hip_atomic_load(p, __ATOMIC_RELAXED, __HIP_MEMORY_SCOPE_AGENT); }
__device__ __forceinline__ unsigned xb_add(unsigned* p, unsigned v) { return __hip_atomic_fetch_add(p, v, __ATOMIC_RELAXED, __HIP_MEMORY_SCOPE_AGENT); }
__device__ __forceinline__ unsigned xb_xcc_id() { return (unsigned)__builtin_amdgcn_s_getreg((3 << 11) | 20) & 0xFu; }
#define XB_SPIN(cond, bar) do { unsigned _sp = 0; while (cond) { __builtin_amdgcn_s_sleep(1); \
    if ((++_sp & 255u) == 0u) { if (xb_ld(&(bar)[XB_TMO])) break; if (_sp > XB_SPIN_CAP) { atomicAdd(&(bar)[XB_TMO], 1u); break; } } } } while (0)
struct XcdBarrier { unsigned* bar; unsigned x; volatile LAS unsigned* st; };
__device__ __forceinline__ XcdBarrier xcd_barrier_post(unsigned* bar, volatile LAS unsigned* st, int g_wave) {
    XcdBarrier b; b.bar = bar; b.x = xb_xcc_id(); b.st = st;
    if (MY_TID() == 0) (void)xb_add(&bar[XB_XCNT(b.x)], 1u);
    return b;
}
__device__ __forceinline__ void xcd_barrier_complete(unsigned* bar, unsigned x, unsigned& nloc, unsigned& nx) {
    const unsigned G = gridDim.x * gridDim.y * gridDim.z;
    unsigned sum, cnt, mine, sp = 0u;
    for (;;) {
        sum = 0u; cnt = 0u; mine = 0u;
#pragma unroll
        for (unsigned j = 0; j < 16; ++j) { const unsigned c = xb_ld(&bar[XB_XCNT(j)]); sum += c; cnt += (c > 0u) ? 1u : 0u; mine = (j == x) ? c : mine; }
        if (sum == G) break;
        __builtin_amdgcn_s_sleep(1);
        if ((++sp & 255u) == 0u) { if (xb_ld(&bar[XB_TMO])) break; if (sp > XB_SPIN_CAP) { atomicAdd(&bar[XB_TMO], 1u); break; } }
    }
    nloc = mine > 0u ? mine : 1u; nx = cnt > 0u ? cnt : 1u;
}
__device__ __forceinline__ void xcd_barrier(const XcdBarrier& b, int g_wave) {
    asm volatile("s_waitcnt vmcnt(0)" ::: "memory");
    __syncthreads();
    if (MY_TID() == 0) {
        unsigned* bar = b.bar;
        __builtin_amdgcn_s_waitcnt(0);
        unsigned nloc = b.st[0], nx = b.st[1];
        if (nloc == 0u) { xcd_barrier_complete(bar, b.x, nloc, nx); b.st[0] = nloc; b.st[1] = nx; }
        const unsigned old = xb_add(&bar[XB_XSUB(b.x)], 1u);
        const unsigned gen = old / nloc;
        if (old + 1u == (gen + 1u) * nloc) {
            __builtin_amdgcn_fence(__ATOMIC_RELEASE, "agent");
            asm volatile("s_waitcnt vmcnt(0)" ::: "memory");
            const unsigned og = xb_add(&bar[XB_TOP], 1u);
            const unsigned tg = og / nx;
            if (og + 1u == (tg + 1u) * nx) xb_add(&bar[XB_TOPGEN], 1u);
            else XB_SPIN(xb_ld(&bar[XB_TOPGEN]) == tg, bar);
            __builtin_amdgcn_fence(__ATOMIC_ACQUIRE, "agent");
            xb_add(&bar[XB_XGEN(b.x)], 1u);
            asm volatile("s_waitcnt vmcnt(0)" ::: "memory");
        } else {
            XB_SPIN(xb_ld(&bar[XB_XGEN(b.x)]) == gen, bar);
            __builtin_amdgcn_fence(__ATOMIC_ACQUIRE, "agent");
            asm volatile("s_waitcnt vmcnt(0)" ::: "memory");
        }
    }
    __syncthreads();
}

struct Args { const float* in[20]; float* out; unsigned char* ws; int ph_lo, ph_hi; };
typedef const Args __attribute__((address_space(4)))* KArgP;
__device__ __forceinline__ KArgP kargs() { KArgP p = (KArgP)__builtin_amdgcn_kernarg_segment_ptr(); asm volatile("" : "+s"(p)); return p; }
enum { I_X = 0, I_C, I_N1G, I_WADA, I_BADA, I_WIN, I_QNG, I_KNG, I_CONVW, I_AOG, I_COG, I_WOUT, I_N2G, I_DWG, I_DWU, I_DWD, I_ROUTER, I_MWG, I_MWU, I_MWD };

__device__ __forceinline__ void gemv_item(const float* wada, float* modp, const LAS float* cact, int it, int lane) {
    const int kc = it & 7, cg = (it >> 3) % 192, l = it / (8 * 192);
    const int n = cg * 64 + lane;
    const float* w = wada + ((size_t)l * DM + kc * 256) * MODW + n;
    float acc[8];
#pragma unroll
    for (int b = 0; b < 8; ++b) acc[b] = 0.f;
#pragma nounroll
    for (int k0 = 0; k0 < 256; k0 += 16) {
        float wv[16];
#pragma unroll
        for (int j = 0; j < 16; ++j) wv[j] = w[(size_t)(k0 + j) * MODW];
#pragma unroll
        for (int j4 = 0; j4 < 16; j4 += 4) {
#pragma unroll
            for (int b = 0; b < 8; ++b) { const f32x4 cv = *(const LAS f32x4*)(cact + b * DM + kc * 256 + k0 + j4);
                acc[b] += cv.x * wv[j4] + cv.y * wv[j4 + 1] + cv.z * wv[j4 + 2] + cv.w * wv[j4 + 3]; }
        }
    }
#pragma unroll
    for (int b = 0; b < 8; ++b) modp[((size_t)(l * 8 + kc) * 8 + b) * MODW + n] = acc[b];
}
constexpr int J_WIN = 16 * 72, J_WOUT = 16 * 32, J_DG = 16 * 88, J_DD = 44 * 32, J_MG = 16 * 64, J_MD = 32 * 32;
constexpr int CV_WIN0 = 0, CV_WOUT0 = CV_WIN0 + J_WIN, CV_DG = CV_WOUT0 + J_WOUT, CV_DD = CV_DG + 2 * J_DG, CV_WIN1 = CV_DD + J_DD, CV_WOUT1 = CV_WIN1 + J_WIN, CV_MG = CV_WOUT1 + J_WOUT, CV_MD = CV_MG + 16 * J_MG, CV_END = CV_MD + 8 * J_MD;
struct CvDesc { const float* W; unsigned char* WT; int K, N, n0, k0, drow0; bool f8; bool nostore; };
__device__ __forceinline__ CvDesc cv_decode(KArgP a, int it, int half) {
    int r = it; CvDesc d; int mode = 0; d.f8 = false; d.nostore = false;
    int winl = -1;
    if (r < CV_WOUT0) { d.W = a->in[I_WIN]; d.K = DM; d.N = IN_W; d.WT = a->ws + WS_WIN; winl = 0; }
    else if (r < CV_DG) { r -= CV_WOUT0; d.W = a->in[I_WOUT]; d.K = DM; d.N = DM; d.WT = a->ws + WS_WOUT; }
    else if (r < CV_DD) { r -= CV_DG; const int u = r / J_DG; r -= u * J_DG; d.W = a->in[u ? I_DWU : I_DWG]; d.K = DM; d.N = FFD; mode = 1 + u; d.WT = a->ws + WS_DGU; d.f8 = MK_FP8_DUP != 0; }
    else if (r < CV_WIN1) { r -= CV_DD; d.W = a->in[I_DWD]; d.K = FFD; d.N = DM; d.WT = a->ws + WS_DDN; d.f8 = MK_FP8_DDN != 0; }
    else if (r < CV_WOUT1) { r -= CV_WIN1; d.W = a->in[I_WIN] + (size_t)DM * IN_W; d.K = DM; d.N = IN_W; d.WT = a->ws + WS_WIN + (size_t)IN_W * DM * 2; winl = 1; }
    else if (r < CV_MG) { r -= CV_WOUT1; d.W = a->in[I_WOUT] + (size_t)DM * DM; d.K = DM; d.N = DM; d.WT = a->ws + WS_WOUT + (size_t)DM * DM * 2; }
    else if (r < CV_MD) { r -= CV_MG; const int q = r / J_MG; r -= q * J_MG; const int e = q >> 1, u = q & 1; d.W = a->in[u ? I_MWU : I_MWG] + (size_t)e * DM * FFE; d.K = DM; d.N = FFE; mode = 1 + u; d.f8 = MK_FP8_MOE != 0;
        d.WT = a->ws + WS_MGU + (size_t)e * 2 * FFE * DM * (MK_FP8_MOE ? 1 : 2); }
    else { r -= CV_MD; const int e = r / J_MD; r -= e * J_MD; d.W = a->in[I_MWD] + (size_t)e * FFE * DM; d.K = FFE; d.N = DM; d.f8 = MK_FP8_MOE != 0; d.WT = a->ws + WS_MDN + (size_t)e * DM * FFE * (MK_FP8_MOE ? 1 : 2); }
    const int nblk = d.N >> 6, kb2 = r / nblk, nb = r - kb2 * nblk;
    d.n0 = nb << 6; d.k0 = (kb2 * 2 + half) << 6;
    if (MK_FP8_QKV && winl >= 0 && d.n0 < QKV_W) { d.f8 = true; d.WT = a->ws + WS_WIN8 + (size_t)winl * QKV_W * DM; }
    d.drow0 = mode ? ((d.n0 >> 7) << 8) + (d.n0 & 127) + (mode == 2 ? 128 : 0) : d.n0;
    if (MK_UFUSE && winl >= 0) {
        if (d.n0 >= OFF_GC) { const int ch = d.n0 - OFF_GC; d.drow0 = OFF_HC + ((ch >> 7) << 8) + 128 + (ch & 127); }
        else if (d.n0 >= OFF_GB) d.drow0 = d.n0 + 1024;
        else if (d.n0 >= OFF_HC) { const int ch = d.n0 - OFF_HC; d.drow0 = OFF_HC + ((ch >> 7) << 8) + (ch & 127); } }
    return d;
}
__device__ __forceinline__ void cv_load(const CvDesc& d, f32x4 (&v)[16], int lane) {
    if (d.f8) {
        const float* src = d.W + (size_t)(d.k0 + 4 * (lane >> 4)) * d.N + d.n0 + (lane & 15) * 4;
#pragma unroll
        for (int i = 0; i < 4; ++i)
#pragma unroll
            for (int r = 0; r < 4; ++r) v[4 * i + r] = __builtin_nontemporal_load((const f32x4*)(src + (size_t)(16 * i + r) * d.N));
    } else {
        const float* src = d.W + (size_t)(d.k0 + (lane >> 4)) * d.N + d.n0 + (lane & 15) * 4;
#pragma unroll
        for (int i = 0; i < 16; ++i) v[i] = __builtin_nontemporal_load((const f32x4*)(src + (size_t)(4 * i) * d.N));
    }
}
__device__ __forceinline__ void cv_process(const CvDesc& d, const f32x4 (&v)[16], LAS float* scr, int lane) {
    if (d.f8) {
        LAS unsigned* T = (LAS unsigned*)scr; const int kq = lane >> 4, c4 = lane & 15;
#pragma unroll
        for (int i = 0; i < 4; ++i) { LAS unsigned* p = T + (4 * c4) * 17 + 4 * i + kq;
            p[0 * 17] = pk4_fp8(v[4 * i][0] * FP8_WSCALE, v[4 * i + 1][0] * FP8_WSCALE, v[4 * i + 2][0] * FP8_WSCALE, v[4 * i + 3][0] * FP8_WSCALE);
            p[1 * 17] = pk4_fp8(v[4 * i][1] * FP8_WSCALE, v[4 * i + 1][1] * FP8_WSCALE, v[4 * i + 2][1] * FP8_WSCALE, v[4 * i + 3][1] * FP8_WSCALE);
            p[2 * 17] = pk4_fp8(v[4 * i][2] * FP8_WSCALE, v[4 * i + 1][2] * FP8_WSCALE, v[4 * i + 2][2] * FP8_WSCALE, v[4 * i + 3][2] * FP8_WSCALE);
            p[3 * 17] = pk4_fp8(v[4 * i][3] * FP8_WSCALE, v[4 * i + 1][3] * FP8_WSCALE, v[4 * i + 2][3] * FP8_WSCALE, v[4 * i + 3][3] * FP8_WSCALE); }
        LDS_WAIT(); asm volatile("" ::: "memory");
        const int q4 = lane & 3;
#pragma unroll
        for (int j = 0; j < 4; ++j) { const int n = (lane >> 2) + 16 * j; const LAS unsigned* sp = T + n * 17 + 4 * q4;
            u32x4 o; o.x = sp[0]; o.y = sp[1]; o.z = sp[2]; o.w = sp[3];
            if (d.nostore) asm volatile("" :: "v"(o)); else __builtin_nontemporal_store(o, (u32x4*)(d.WT + (size_t)(d.drow0 + n) * d.K + d.k0 + 16 * q4)); }
        LDS_WAIT(); asm volatile("" ::: "memory");
        return;
    }
#pragma unroll
    for (int i = 0; i < 16; ++i) { LAS float* p = scr + (4 * i + (lane >> 4)) * 65 + (lane & 15) * 4; p[0] = v[i].x; p[1] = v[i].y; p[2] = v[i].z; p[3] = v[i].w; }
    LDS_WAIT(); asm volatile("" ::: "memory");
    { const int c = lane & 7;
#pragma unroll
        for (int j = 0; j < 8; ++j) { const int n = (lane >> 3) + 8 * j; const LAS float* sp = scr + (8 * c) * 65 + n;
            u32x4 o; o.x = cvt_pk_bf16(sp[0 * 65], sp[1 * 65]); o.y = cvt_pk_bf16(sp[2 * 65], sp[3 * 65]); o.z = cvt_pk_bf16(sp[4 * 65], sp[5 * 65]); o.w = cvt_pk_bf16(sp[6 * 65], sp[7 * 65]);
            __builtin_nontemporal_store(o, (u32x4*)((bf16_t*)d.WT + (size_t)(d.drow0 + n) * d.K + d.k0 + 8 * c)); }
    }
    LDS_WAIT(); asm volatile("" ::: "memory");
}
__device__ __forceinline__ void convert_items(KArgP a, LAS unsigned char* lds, int wg, int nwg, int g_wave, int first, int last, bool nostore = false) {
    const int tid = opaque_tid(), lane = tid & 63, wave = __builtin_amdgcn_readfirstlane(tid >> 6);
    const int gw = wg * 8 + wave, NGW = nwg * 8;
    LAS float* scr = (LAS float*)(lds + wave * 16640);
    const int it0 = first + (NGW - 1 - gw);
    if (it0 >= last) return;
    const int nsub = 2 * ((last - 1 - it0) / NGW + 1);
    f32x4 vA[16], vB[16], vC[16];
    CvDesc dA, dB, dC;
#define CV_ISSUE(D, V, q) do { D = cv_decode(a, it0 + ((q) >> 1) * NGW, (q) & 1); D.nostore = nostore; cv_load(D, V, lane); } while (0)
    CV_ISSUE(dA, vA, 0);
    if (1 < nsub) CV_ISSUE(dB, vB, 1);
    for (int q = 0; q < nsub; q += 3) {
        if (q + 2 < nsub) CV_ISSUE(dC, vC, q + 2);
        __builtin_amdgcn_sched_barrier(0);
        cv_process(dA, vA, scr, lane);
        __builtin_amdgcn_sched_barrier(0);
        if (q + 1 >= nsub) break;
        if (q + 3 < nsub) CV_ISSUE(dA, vA, q + 3);
        __builtin_amdgcn_sched_barrier(0);
        cv_process(dB, vB, scr, lane);
        __builtin_amdgcn_sched_barrier(0);
        if (q + 2 >= nsub) break;
        if (q + 4 < nsub) CV_ISSUE(dB, vB, q + 4);
        __builtin_amdgcn_sched_barrier(0);
        cv_process(dC, vC, scr, lane);
        __builtin_amdgcn_sched_barrier(0);
    }
#undef CV_ISSUE
}
__device__ __forceinline__ void cv_probe_loads(KArgP a, int G, int g_wave, int shape) {
    const int tid = opaque_tid(), lane = tid & 63, wave = __builtin_amdgcn_readfirstlane(tid >> 6);
    const int gw = blockIdx.x * 8 + wave, NGW = G * 8;
    for (int it = (NGW - 1 - gw); it < 16 * 1024; it += NGW) {
        const int q = it >> 10, r = it & 1023, e = q >> 1, u = q & 1;
        const float* W = a->in[u ? I_MWU : I_MWG] + (size_t)e * DM * FFE;
        const float* src; size_t step;
        if (shape == 0 || shape >= 10) { const int kb = r >> 6, nb = r & 63; src = W + (size_t)(kb * 128 + (lane >> 4)) * FFE + nb * 64 + (lane & 15) * 4; step = (size_t)4 * FFE; }
        else if (shape == 1) { const int kb = r >> 5, nb = r & 31; src = W + (size_t)(kb * 64 + (lane >> 5)) * FFE + nb * 128 + (lane & 31) * 4; step = (size_t)2 * FFE; }
        else if (shape == 3) { src = W + (size_t)r * 8192 + lane * 4; step = 256; }
        else { const int kb = r >> 4, nb = r & 15; src = W + (size_t)(kb * 32) * FFE + nb * 256 + lane * 4; step = (size_t)FFE; }
        const int depth = shape == 10 ? 8 : (shape == 11 ? 16 : 32);
        for (int i0 = 0; i0 < 32; i0 += depth) {
            f32x4 v[32];
            if (depth == 8) {
#pragma unroll
                for (int i = 0; i < 8; ++i) v[i] = __builtin_nontemporal_load((const f32x4*)(src + (i0 + i) * step));
#pragma unroll
                for (int i = 0; i < 8; ++i) asm volatile("" :: "v"(v[i]));
            } else if (depth == 16) {
#pragma unroll
                for (int i = 0; i < 16; ++i) v[i] = __builtin_nontemporal_load((const f32x4*)(src + (i0 + i) * step));
#pragma unroll
                for (int i = 0; i < 16; ++i) asm volatile("" :: "v"(v[i]));
            } else {
#pragma unroll
                for (int i = 0; i < 32; ++i) v[i] = __builtin_nontemporal_load((const f32x4*)(src + i * step));
#pragma unroll
                for (int i = 0; i < 32; ++i) asm volatile("" :: "v"(v[i]));
            }
        }
    }
}
__device__ __forceinline__ void p0_prologue(KArgP a, LAS unsigned char* lds, int G, int g_wave, int skip  ) {
    const int tid = opaque_tid(), lane = tid & 63, wave = __builtin_amdgcn_readfirstlane(tid >> 6);
    const int gw = blockIdx.x * 8 + wave, NGW = G * 8;
    LAS float* cact = (LAS float*)lds;
    {
        const float* cin = a->in[I_C];
#pragma nounroll
        for (int i0 = 0; i0 < BATCH * DM; i0 += 16 * 512) { float cv[16];
#pragma unroll
            for (int k = 0; k < 16; ++k) cv[k] = cin[i0 + k * 512 + tid];
#pragma unroll
            for (int k = 0; k < 16; ++k) cact[i0 + k * 512 + tid] = cv[k] / (1.0f + __expf(-cv[k])); } }
    __syncthreads();
    float* modp = (float*)(a->ws + WS_MODP);
    if (skip != 1 && skip < 3) for (int it = gw; it < 2 * 192 * 8; it += NGW) gemv_item(a->in[I_WADA], modp, cact, it, lane);
    __syncthreads();
    if (skip >= 7) cv_probe_loads(a, G, g_wave, skip - 7);
    else if (skip >= 3) { if (skip != 6 || blockIdx.x < 32) convert_items(a, lds, (int)blockIdx.x, skip == 6 ? 32 : G, g_wave, CV_MG, skip == 6 ? CV_MG + (CV_END - CV_MG) / 8 : CV_END, skip == 4); }
    else if (skip != 2) convert_items(a, lds, (int)blockIdx.x, G, g_wave, CV_WIN0, (MK_CVSPLIT && G == 256) ? CV_WOUT0 + (int)((long)(CV_END - CV_WOUT0) * MK_CVP0 / 100) : CV_END);
}

template <bool FROM_PARTIALS, bool ROUTER, int OUT8 = 0  , bool XIN_BF = false  >
__device__ __forceinline__ void norm_pass(KArgP a, int l, int which  , const void* xin_, LAS unsigned char* lds, int G, int g_wave) {
    const int tid = opaque_tid(), lane = tid & 63, wave = __builtin_amdgcn_readfirstlane(tid >> 6);
    LAS float* Amul = (LAS float*)lds; LAS float* Badd = Amul + DM; LAS float* rT = Badd + DM;
    const float* gn = a->in[which ? I_N2G : I_N1G] + (size_t)l * DM;
    const float* modp = (const float*)(a->ws + WS_MODP); float* modf = (float*)(a->ws + WS_MODF);
    const float* bada = a->in[I_BADA];
    bf16_t* H = (bf16_t*)(a->ws + WS_H); unsigned char* H8 = a->ws + WS_H8;
    if (FROM_PARTIALS) {
        for (int idx = blockIdx.x * 512 + tid; idx < 2 * 8 * MODW; idx += G * 512) { const int n = idx % MODW, lb = idx / MODW, ll = lb >> 3, b = lb & 7;
            float s = bada[(size_t)ll * MODW + n];
#pragma unroll
            for (int kc = 0; kc < 8; ++kc) s += modp[((size_t)(ll * 8 + kc) * 8 + b) * MODW + n];
            modf[idx] = s; }
    }
    if (ROUTER) { const float* rw = a->in[I_ROUTER];
#pragma nounroll
        for (int i0 = 0; i0 < DM * NEXP; i0 += 16 * 512) { float rv[16];
#pragma unroll
            for (int k = 0; k < 16; ++k) rv[k] = rw[i0 + k * 512 + tid];
#pragma unroll
            for (int k = 0; k < 16; ++k) { const int i = i0 + k * 512 + tid; rT[(i & 7) * DM + (i >> 3)] = rv[k]; } } }
    int* sel = (int*)(a->ws + WS_ROUTE + RT_SEL); f32x2* wts = (f32x2*)(a->ws + WS_ROUTE + RT_WTS);
    for (int chunk0 = blockIdx.x; chunk0 < M / 64; chunk0 += G) { const int chunk = (G == 256) ? ((chunk0 & 7) << 5) + (chunk0 >> 3) : chunk0;
        const int b = chunk >> 5;
        u32x4 cw[4]; f32x4 cf[4][2];
#define NORM_LOAD(W, F, row_) do { _Pragma("unroll") for (int j = 0; j < 4; ++j) { \
            if (XIN_BF) W[j] = *(const u32x4*)((const bf16_t*)xin_ + (size_t)(row_) * DM + 8 * lane + 512 * j); \
            else { const float* xr = (const float*)xin_ + (size_t)(row_) * DM + 8 * lane; F[j][0] = *(const f32x4*)(xr + 512 * j); F[j][1] = *(const f32x4*)(xr + 512 * j + 4); } } } while (0)
        NORM_LOAD(cw, cf, chunk * 64 + wave * 8);
        __syncthreads();
#pragma unroll
        for (int col = tid; col < DM; col += 512) { float sh, sc;
            const int ish = (which ? 3 : 0) * DM + col, isc = ish + DM;
            if (FROM_PARTIALS) { sh = bada[(size_t)l * MODW + ish]; sc = bada[(size_t)l * MODW + isc];
#pragma unroll
                for (int kc = 0; kc < 8; ++kc) { sh += modp[((size_t)(l * 8 + kc) * 8 + b) * MODW + ish]; sc += modp[((size_t)(l * 8 + kc) * 8 + b) * MODW + isc]; } }
            else { sh = modf[(size_t)(l * 8 + b) * MODW + ish]; sc = modf[(size_t)(l * 8 + b) * MODW + isc]; }
            Amul[col] = gn[col] * (1.0f + sc); Badd[col] = sh; }
        __syncthreads();
#pragma nounroll
        for (int i = 0; i < 8; ++i) { const int row = chunk * 64 + wave * 8 + i;
            u32x4 nw[4]; f32x4 nf[4][2];
#pragma unroll
            for (int j = 0; j < 4; ++j) { nw[j] = cw[j]; nf[j][0] = cf[j][0]; nf[j][1] = cf[j][1]; }
            if (i + 1 < 8) NORM_LOAD(nw, nf, row + 1);
            f32x4 v[4][2]; float ss = 0.f;
#pragma unroll
            for (int j = 0; j < 4; ++j) {
                if (XIN_BF) { const u32x4 w = cw[j];
                    v[j][0] = (f32x4){bf_lo(w.x), bf_hi(w.x), bf_lo(w.y), bf_hi(w.y)}; v[j][1] = (f32x4){bf_lo(w.z), bf_hi(w.z), bf_lo(w.w), bf_hi(w.w)}; }
                else { v[j][0] = cf[j][0]; v[j][1] = cf[j][1]; }
                ss += (v[j][0].x * v[j][0].x + v[j][0].y * v[j][0].y) + (v[j][0].z * v[j][0].z + v[j][0].w * v[j][0].w) + (v[j][1].x * v[j][1].x + v[j][1].y * v[j][1].y) + (v[j][1].z * v[j][1].z + v[j][1].w * v[j][1].w); }
            ss = wave_sum(ss);
            const float rstd = rsqrtf(ss * (1.0f / DM) + EPS);
            float lg[8];
#pragma unroll
            for (int e = 0; e < 8; ++e) lg[e] = 0.f;
#pragma unroll
            for (int j = 0; j < 4; ++j) { const int col = 8 * lane + 512 * j;
                const f32x4 a0 = *(const LAS f32x4*)(Amul + col), a1 = *(const LAS f32x4*)(Amul + col + 4), b0 = *(const LAS f32x4*)(Badd + col), b1 = *(const LAS f32x4*)(Badd + col + 4);
                const f32x4 h0 = v[j][0] * rstd * a0 + b0, h1 = v[j][1] * rstd * a1 + b1;
                if (OUT8 >= 1) { u32x2 w; w.x = pk4_fp8(h0.x * FP8_ASCALE, h0.y * FP8_ASCALE, h0.z * FP8_ASCALE, h0.w * FP8_ASCALE); w.y = pk4_fp8(h1.x * FP8_ASCALE, h1.y * FP8_ASCALE, h1.z * FP8_ASCALE, h1.w * FP8_ASCALE);
                    *(u32x2*)((OUT8 == 2 ? H8 : (unsigned char*)H) + (size_t)row * DM + col) = w; }
                if (OUT8 != 1) { u32x4 w; w.x = cvt_pk_bf16(h0.x, h0.y); w.y = cvt_pk_bf16(h0.z, h0.w); w.z = cvt_pk_bf16(h1.x, h1.y); w.w = cvt_pk_bf16(h1.z, h1.w);
                    *(u32x4*)(H + (size_t)row * DM + col) = w; }
                if (ROUTER) {
#pragma unroll
                    for (int e = 0; e < 8; ++e) { const f32x4 r0 = *(const LAS f32x4*)(rT + e * DM + col), r1 = *(const LAS f32x4*)(rT + e * DM + col + 4);
                        lg[e] += (h0.x * r0.x + h0.y * r0.y) + (h0.z * r0.z + h0.w * r0.w) + (h1.x * r1.x + h1.y * r1.y) + (h1.z * r1.z + h1.w * r1.w); }
                    asm volatile("" ::: "memory"); } }
            if (ROUTER) {
#pragma unroll
                for (int e = 0; e < 8; ++e) lg[e] = wave_sum(lg[e]);
                float m0 = lg[0]; int e0 = 0;
#pragma unroll
                for (int e = 1; e < 8; ++e) if (lg[e] > m0) { m0 = lg[e]; e0 = e; }
                float m1 = -3.0e38f; int e1 = 0;
#pragma unroll
                for (int e = 0; e < 8; ++e) if (e != e0 && lg[e] > m1) { m1 = lg[e]; e1 = e; }
                const float w0 = 1.0f / (1.0f + __expf(m1 - m0));
                if (lane == 0) { sel[row] = e0 | (e1 << 8); wts[row] = (f32x2){w0, 1.0f - w0}; }
            }
#pragma unroll
            for (int j = 0; j < 4; ++j) { cw[j] = nw[j]; cf[j][0] = nf[j][0]; cf[j][1] = nf[j][1]; }
        }
#undef NORM_LOAD
    }
}

__device__ __forceinline__ void route_pass(KArgP a, LAS unsigned char* lds, int G, int g_wave) {
    const int tid = opaque_tid(), lane = tid & 63, wave = __builtin_amdgcn_readfirstlane(tid >> 6);
    const int* sel = (const int*)(a->ws + WS_ROUTE + RT_SEL); int* posof = (int*)(a->ws + WS_ROUTE + RT_POSOF); int* rowlist = (int*)(a->ws + WS_ROUTE + RT_ROWLIST); int* tso = (int*)(a->ws + WS_ROUTE + RT_TS);
    LAS int* sh = (LAS int*)lds;
    int tot[8], bef1[8];
    const bool one = (G == M / 64);
    const int lim1 = one ? (int)blockIdx.x * 64 : 0;
#pragma unroll
    for (int e = 0; e < 8; ++e) { tot[e] = 0; bef1[e] = 0; }
#pragma nounroll
    for (int it = 0; it < M / 512; it += 16) { int sv[16];
#pragma unroll
        for (int k = 0; k < 16; ++k) sv[k] = sel[(it + k) * 512 + wave * 64 + lane];
#pragma unroll
        for (int k = 0; k < 16; ++k) { const int e0 = sv[k] & 255, e1 = sv[k] >> 8; const bool isbef = ((it + k) * 512 + wave * 64) < lim1;
#pragma unroll
            for (int e = 0; e < 8; ++e) { const int c = __popcll(__ballot(e0 == e)) + __popcll(__ballot(e1 == e)); tot[e] += c; bef1[e] += isbef ? c : 0; } } }
    __syncthreads();
    if (lane == 0) {
#pragma unroll
        for (int e = 0; e < 8; ++e) { sh[wave * 8 + e] = tot[e]; sh[128 + wave * 8 + e] = bef1[e]; } }
    __syncthreads();
    int T[8], ts[9]; ts[0] = 0;
#pragma unroll
    for (int e = 0; e < 8; ++e) { int s = 0;
#pragma unroll
        for (int w = 0; w < 8; ++w) s += sh[w * 8 + e];
        T[e] = s; ts[e + 1] = ts[e] + ((s + 255) >> 8); }
    for (int chunk = blockIdx.x; chunk < M / 64; chunk += G) {
        if (!one) {
        int bef[8];
#pragma unroll
        for (int e = 0; e < 8; ++e) bef[e] = 0;
        for (int base = wave * 64; base < chunk * 64; base += 512) { const int s = sel[base + lane]; const int e0 = s & 255, e1 = s >> 8;
#pragma unroll
            for (int e = 0; e < 8; ++e) bef[e] += __popcll(__ballot(e0 == e)) + __popcll(__ballot(e1 == e)); }
        __syncthreads();
        if (lane == 0) {
#pragma unroll
            for (int e = 0; e < 8; ++e) sh[64 + wave * 8 + e] = bef[e]; }
        __syncthreads(); }
        if (wave == 0) {
            const int row = chunk * 64 + lane; const int s = sel[row]; const int e0 = s & 255, e1 = s >> 8;
            const unsigned long long lt = (1ull << lane) - 1ull;
            int p0 = 0, p1 = 0;
#pragma unroll
            for (int e = 0; e < 8; ++e) { int B = 0;
#pragma unroll
                for (int w = 0; w < 8; ++w) B += sh[(one ? 128 : 64) + w * 8 + e];
                const unsigned long long m0 = __ballot(e0 == e), m1 = __ballot(e1 == e); const int basee = ts[e] * 256 + B;
                if (e0 == e) p0 = basee + __popcll(m0 & lt);
                if (e1 == e) p1 = basee + __popcll(m0) + __popcll(m1 & lt); }
            rowlist[p0] = row; rowlist[p1] = row; posof[row * 2] = p0; posof[row * 2 + 1] = p1;
        }
    }
    if (blockIdx.x < 8 && wave == 1) {
        int start = 0, end = 0;
#pragma unroll
        for (int e = 0; e < 8; ++e) if (e == (int)blockIdx.x) { start = ts[e] * 256 + T[e]; end = ts[e + 1] * 256; }
        for (int i = start + lane; i < end; i += 64) rowlist[i] = 0;
    }
    if (blockIdx.x == 0 && tid == 0) {
#pragma unroll
        for (int e = 0; e < 9; ++e) tso[e] = ts[e]; }
}

__device__ __forceinline__ void prep_pass(KArgP a, int l, LAS unsigned char* lds, int G, int g_wave) {
    const int tid = opaque_tid(), lane = tid & 63, wave = __builtin_amdgcn_readfirstlane(tid >> 6);
    LAS f32x2* tab = (LAS f32x2*)lds;
    for (int i = tid; i < 64 * 32; i += 512) { const int pos = i >> 5, fi = i & 31;
        const float inv = exp2f(-(float)fi * (13.287712379549449f / 32.0f));
        const float ang = (float)pos * inv; tab[i] = (f32x2){__cosf(ang), __sinf(ang)}; }
    __syncthreads();
    const bf16_t* P = (const bf16_t*)(a->ws + WS_P); bf16_t* MIX = (bf16_t*)(a->ws + WS_MIX); bf16_t* Qo = (bf16_t*)(a->ws + WS_Q); bf16_t* KVo = (bf16_t*)(a->ws + WS_KV);
    const float* qg = a->in[I_QNG] + l * HD; const float* kg = a->in[I_KNG] + l * HD;
    const float* cw = a->in[I_CONVW] + (size_t)l * 3 * 1024; const float* cog = a->in[I_COG] + (size_t)l * 1024;
    const int sq = (lane >> 2) & 1, cq = lane & 3;
    float gqa[8], gqb[8], gka[8], gkb[8];
#pragma unroll
    for (int j = 0; j < 8; ++j) { const int d = sq * 64 + 8 * cq + j; gqa[j] = qg[d]; gqb[j] = qg[d + 32]; gka[j] = kg[d]; gkb[j] = kg[d + 32]; }
    float w0[2][8], w1[2][8], w2[2][8], cg[2][8];
#pragma unroll
    for (int jc = 0; jc < 2; ++jc)
#pragma unroll
        for (int q = 0; q < 8; ++q) { const int ch = 8 * lane + 512 * jc + q; w0[jc][q] = cw[ch]; w1[jc][q] = cw[1024 + ch]; w2[jc][q] = cw[2048 + ch]; cg[jc][q] = cog[ch]; }
    for (int chunk0 = blockIdx.x; chunk0 < M / 64; chunk0 += G) { const int chunk = (G == 256) ? ((chunk0 & 7) << 5) + (chunk0 >> 3) : chunk0;
        const int row0 = chunk * 64 + wave * 8;
#pragma nounroll
        for (int g5 = 0; g5 < 10; g5 += 5) {
        u32x4 wa_[5], wb_[5];
#pragma unroll
        for (int ii = 0; ii < 5; ++ii) { const int i = g5 + ii;
            const bool isq = i < 8;
            const int row = isq ? row0 + i : row0 + (i - 8) * 4 + (lane >> 4);
            const int hcol = isq ? (lane >> 3) * HD : OFF_K + ((lane >> 3) & 1) * HD;
            const bf16_t* base = P + (size_t)row * PW + hcol + sq * 64 + 8 * cq;
            wa_[ii] = *(const u32x4*)base; wb_[ii] = *(const u32x4*)(base + 32); }
#pragma unroll
        for (int ii = 0; ii < 5; ++ii) { const int i = g5 + ii;
            const bool isq = i < 8;
            const int row = isq ? row0 + i : row0 + (i - 8) * 4 + (lane >> 4);
            const int t = row & (SEQ - 1), pos = sq ? (t & 63) : (t >> 6);
            bf16_t* obase = (isq ? Qo + (size_t)row * 1024 + (lane >> 3) * HD : KVo + (size_t)row * 512 + ((lane >> 3) & 1) * HD) + sq * 64 + 8 * cq;
            const u32x4 wa = wa_[ii], wb = wb_[ii];
            float xa[8], xb[8]; float ss = 0.f;
#pragma unroll
            for (int q = 0; q < 4; ++q) { xa[2 * q] = bf_lo(wa[q]); xa[2 * q + 1] = bf_hi(wa[q]); xb[2 * q] = bf_lo(wb[q]); xb[2 * q + 1] = bf_hi(wb[q]); }
#pragma unroll
            for (int j = 0; j < 8; ++j) ss += xa[j] * xa[j] + xb[j] * xb[j];
            ss += swz_xor<1>(ss); ss += swz_xor<2>(ss); ss += swz_xor<4>(ss);
            const float rs = rsqrtf(ss * (1.0f / HD) + EPS);
            const LAS f32x4* tp = (const LAS f32x4*)(tab + pos * 32 + 8 * cq);
            float ya[8], yb[8];
#pragma unroll
            for (int q = 0; q < 4; ++q) { const f32x4 cs = tp[q];
#pragma unroll
                for (int e = 0; e < 2; ++e) { const int j = 2 * q + e; const float co = e ? cs.z : cs.x, si = e ? cs.w : cs.y;
                    const float a_ = xa[j] * rs * (isq ? gqa[j] : gka[j]), b_ = xb[j] * rs * (isq ? gqb[j] : gkb[j]);
                    ya[j] = a_ * co - b_ * si; yb[j] = b_ * co + a_ * si; } }
            u32x4 oa, ob;
#pragma unroll
            for (int q = 0; q < 4; ++q) { oa[q] = cvt_pk_bf16(ya[2 * q], ya[2 * q + 1]); ob[q] = cvt_pk_bf16(yb[2 * q], yb[2 * q + 1]); }
            *(u32x4*)obase = oa; *(u32x4*)(obase + 32) = ob;
        } }
        if (lane < 32) {
#pragma unroll
            for (int i = 0; i < 8; ++i) *(u32x4*)(KVo + (size_t)(row0 + i) * 512 + 256 + 8 * lane) = *(const u32x4*)(P + (size_t)(row0 + i) * PW + OFF_V + 8 * lane); }
        static_assert(MK_UFUSE, "the conv stage reads the fused u = C * h columns");
        const int t0 = row0 & (SEQ - 1);
#pragma unroll
        for (int jc = 0; jc < 2; ++jc) { const int ch = 8 * lane + 512 * jc;
#pragma nounroll
            for (int hh = 0; hh < 2; ++hh) {
            u32x4 ur[6], gr[4];
#pragma unroll
            for (int r = 0; r < 6; ++r) { const bool ok = (r == 0) ? (hh == 1 || t0 > 0) : ((r == 5) ? (hh == 0 || t0 + 8 < SEQ) : true);
                if (ok) ur[r] = *(const u32x4*)(P + (size_t)(row0 + 4 * hh + r - 1) * PW + OFF_U + ch); else ur[r] = (u32x4){0u, 0u, 0u, 0u}; }
#pragma unroll
            for (int i = 0; i < 4; ++i) gr[i] = *(const u32x4*)(P + (size_t)(row0 + 4 * hh + i) * PW + 2560 + ch);
#pragma unroll
            for (int i = 0; i < 4; ++i) {
                float y[8]; float ss = 0.f;
#pragma unroll
                for (int q = 0; q < 8; ++q) { const unsigned wp = ur[i][q >> 1], wc_ = ur[i + 1][q >> 1], wn = ur[i + 2][q >> 1], wg = gr[i][q >> 1];
                    const float up_ = (q & 1) ? bf_hi(wp) : bf_lo(wp), uc_ = (q & 1) ? bf_hi(wc_) : bf_lo(wc_), un_ = (q & 1) ? bf_hi(wn) : bf_lo(wn), gb = (q & 1) ? bf_hi(wg) : bf_lo(wg);
                    y[q] = gb * (up_ * w0[jc][q] + uc_ * w1[jc][q] + un_ * w2[jc][q]); ss += y[q] * y[q]; }
                ss = sum16(ss);
                const float rs = rsqrtf(ss * (1.0f / 128.0f) + EPS);
                u32x4 o; o.x = cvt_pk_bf16(y[0] * rs * cg[jc][0], y[1] * rs * cg[jc][1]); o.y = cvt_pk_bf16(y[2] * rs * cg[jc][2], y[3] * rs * cg[jc][3]);
                o.z = cvt_pk_bf16(y[4] * rs * cg[jc][4], y[5] * rs * cg[jc][5]); o.w = cvt_pk_bf16(y[6] * rs * cg[jc][6], y[7] * rs * cg[jc][7]);
                *(u32x4*)(MIX + (size_t)(row0 + 4 * hh + i) * DM + 1024 + ch) = o; } } }
    }
}

__device__ __forceinline__ void combine_pass(KArgP a, int l, int G, int g_wave) {
    const int tid = opaque_tid(), lane = tid & 63, wave = __builtin_amdgcn_readfirstlane(tid >> 6);
    const int* posof = (const int*)(a->ws + WS_ROUTE + RT_POSOF); const f32x2* wts = (const f32x2*)(a->ws + WS_ROUTE + RT_WTS);
    const bf16_t* Y = (const bf16_t*)(a->ws + WS_Y); const float* modf = (const float*)(a->ws + WS_MODF);
    if (MK_XBF && !MK_Y8 && MK_CMBPIPE && M == 64 * G) {
        const bf16_t* XRp = (const bf16_t*)(a->ws + WS_XR);
        const int r0 = blockIdx.x * 8 + wave, st = G * 8;
        int q0[8], q1[8]; f32x2 ww[8];
#pragma unroll
        for (int k = 0; k < 8; ++k) { const int row = r0 + k * st; q0[k] = posof[row * 2]; q1[k] = posof[row * 2 + 1]; ww[k] = wts[row]; }
        u32x4 ay0[4], ay1[4], ax[4], by0[4], by1[4], bx[4]; f32x4 aga[4], agb[4], bga[4], bgb[4];
#define CMB_LOAD(Y0, Y1, X, GA, GB, k) do { const int row_ = r0 + (k) * st; const float* g2_ = modf + (size_t)(l * 8 + (row_ >> 11)) * MODW + 5 * DM; \
        _Pragma("unroll") for (int j = 0; j < 4; ++j) { const int col = 8 * lane + 512 * j; \
            Y0[j] = *(const u32x4*)(Y + (size_t)q0[k] * DM + col); Y1[j] = *(const u32x4*)(Y + (size_t)q1[k] * DM + col); X[j] = *(const u32x4*)(XRp + (size_t)row_ * DM + col); \
            GA[j] = *(const f32x4*)(g2_ + col); GB[j] = *(const f32x4*)(g2_ + col + 4); } } while (0)
#define CMB_DO(Y0, Y1, X, GA, GB, k) do { float* o_ = a->out + (size_t)(r0 + (k) * st) * DM; const f32x2 w_ = ww[k]; \
        _Pragma("unroll") for (int j = 0; j < 4; ++j) { const int col = 8 * lane + 512 * j; const u32x4 y0 = Y0[j], y1 = Y1[j], xw = X[j]; \
            const f32x4 ya0 = (f32x4){bf_lo(y0.x), bf_hi(y0.x), bf_lo(y0.y), bf_hi(y0.y)}, yb0 = (f32x4){bf_lo(y0.z), bf_hi(y0.z), bf_lo(y0.w), bf_hi(y0.w)}; \
            const f32x4 ya1 = (f32x4){bf_lo(y1.x), bf_hi(y1.x), bf_lo(y1.y), bf_hi(y1.y)}, yb1 = (f32x4){bf_lo(y1.z), bf_hi(y1.z), bf_lo(y1.w), bf_hi(y1.w)}; \
            const f32x4 xa = (f32x4){bf_lo(xw.x), bf_hi(xw.x), bf_lo(xw.y), bf_hi(xw.y)}, xb = (f32x4){bf_lo(xw.z), bf_hi(xw.z), bf_lo(xw.w), bf_hi(xw.w)}; \
            *(f32x4*)(o_ + col) = xa + GA[j] * (ya0 * w_.x + ya1 * w_.y); *(f32x4*)(o_ + col + 4) = xb + GB[j] * (yb0 * w_.x + yb1 * w_.y); } } while (0)
        CMB_LOAD(ay0, ay1, ax, aga, agb, 0);
#pragma unroll
        for (int k = 0; k < 8; k += 2) {
            CMB_LOAD(by0, by1, bx, bga, bgb, k + 1); __builtin_amdgcn_sched_barrier(0);
            CMB_DO(ay0, ay1, ax, aga, agb, k); __builtin_amdgcn_sched_barrier(0);
            if (k + 2 < 8) { CMB_LOAD(ay0, ay1, ax, aga, agb, k + 2); } __builtin_amdgcn_sched_barrier(0);
            CMB_DO(by0, by1, bx, bga, bgb, k + 1); __builtin_amdgcn_sched_barrier(0);
        }
#undef CMB_LOAD
#undef CMB_DO
        return;
    }
    for (int row = blockIdx.x * 8 + wave; row < M; row += G * 8) {
        const int b = row >> 11; const int p0 = posof[row * 2], p1 = posof[row * 2 + 1]; const f32x2 w = wts[row];
        const float* g2 = modf + (size_t)(l * 8 + b) * MODW + 5 * DM;
        float* o = a->out + (size_t)row * DM;
#pragma unroll
        for (int j = 0; j < 4; ++j) { const int col = 8 * lane + 512 * j;
            f32x4 ya0, yb0, ya1, yb1;
            if (MK_Y8) { const unsigned char* Y8 = (const unsigned char*)Y; const u32x2 q0 = *(const u32x2*)(Y8 + (size_t)p0 * DM + col), q1 = *(const u32x2*)(Y8 + (size_t)p1 * DM + col);
                const f32x2 a0 = __builtin_amdgcn_cvt_pk_f32_fp8((int)q0.x, false), a1 = __builtin_amdgcn_cvt_pk_f32_fp8((int)q0.x, true), a2 = __builtin_amdgcn_cvt_pk_f32_fp8((int)q0.y, false), a3 = __builtin_amdgcn_cvt_pk_f32_fp8((int)q0.y, true);
                const f32x2 b0 = __builtin_amdgcn_cvt_pk_f32_fp8((int)q1.x, false), b1 = __builtin_amdgcn_cvt_pk_f32_fp8((int)q1.x, true), b2 = __builtin_amdgcn_cvt_pk_f32_fp8((int)q1.y, false), b3 = __builtin_amdgcn_cvt_pk_f32_fp8((int)q1.y, true);
                constexpr float r = 1.0f / FP8_YSCALE;
                ya0 = (f32x4){a0.x, a0.y, a1.x, a1.y} * r; yb0 = (f32x4){a2.x, a2.y, a3.x, a3.y} * r; ya1 = (f32x4){b0.x, b0.y, b1.x, b1.y} * r; yb1 = (f32x4){b2.x, b2.y, b3.x, b3.y} * r; }
            else { const u32x4 y0 = *(const u32x4*)(Y + (size_t)p0 * DM + col), y1 = *(const u32x4*)(Y + (size_t)p1 * DM + col);
                ya0 = (f32x4){bf_lo(y0.x), bf_hi(y0.x), bf_lo(y0.y), bf_hi(y0.y)}; yb0 = (f32x4){bf_lo(y0.z), bf_hi(y0.z), bf_lo(y0.w), bf_hi(y0.w)};
                ya1 = (f32x4){bf_lo(y1.x), bf_hi(y1.x), bf_lo(y1.y), bf_hi(y1.y)}; yb1 = (f32x4){bf_lo(y1.z), bf_hi(y1.z), bf_lo(y1.w), bf_hi(y1.w)}; }
            const f32x4 ga = *(const f32x4*)(g2 + col), gb = *(const f32x4*)(g2 + col + 4);
            f32x4 xa, xb;
            if (MK_XBF) { const u32x4 w_ = *(const u32x4*)((const bf16_t*)(a->ws + WS_XR) + (size_t)row * DM + col); xa = (f32x4){bf_lo(w_.x), bf_hi(w_.x), bf_lo(w_.y), bf_hi(w_.y)}; xb = (f32x4){bf_lo(w_.z), bf_hi(w_.z), bf_lo(w_.w), bf_hi(w_.w)}; }
            else { xa = *(const f32x4*)(o + col); xb = *(const f32x4*)(o + col + 4); }
            xa = xa + ga * (ya0 * w.x + ya1 * w.y); xb = xb + gb * (yb0 * w.x + yb1 * w.y);
            *(f32x4*)(o + col) = xa; *(f32x4*)(o + col + 4) = xb; }
    }
}

constexpr int NPHASE = 21;
__global__ void __launch_bounds__(512, 2) mk_fwd(Args args) {
    extern __shared__ __attribute__((aligned(16))) unsigned char lds_raw[];
    LAS unsigned char* lds = (LAS unsigned char*)lds_raw;
    const int tid = threadIdx.x, G = gridDim.x;
    const int g_wave = __builtin_amdgcn_readfirstlane(tid >> 6);
    volatile LAS unsigned* MISC = (volatile LAS unsigned*)(lds + MISC_OFF);
    for (int u = tid; u < (LDS_BYTES - LDSCTL_OFF) / 4; u += 512) ((LAS unsigned*)(lds + LDSCTL_OFF))[u] = 0u;
    __syncthreads();
    const int lo = args.ph_lo, hi = args.ph_hi;
    unsigned* barw = (unsigned*)(args.ws + WS_CTL) + CW_BAR;
    XcdBarrier bar; bar.bar = barw; bar.x = 0; bar.st = nullptr;
    if (hi - lo > 1) bar = xcd_barrier_post(barw, MISC + 8, g_wave);
#ifndef MK_EN
#define MK_EN 0xffffffffu
#endif
#define EN(k) (((MK_EN) >> (k)) & 1u)
#define IN(p) (lo <= (p) && (p) < hi)
#define SEAM(p) do { if ((p) + 1 < hi) xcd_barrier(bar, g_wave); } while (0)
#define A_ (*ap_)
#define WSP(T, off) ((T*)(A_.ws + (off)))

#ifndef MK_DUP
#define MK_DUP 0u
#endif
#define DUP(k) (((MK_DUP) >> (k)) & 1u)
#ifndef MK_VAR
#define MK_VAR 0
#endif
#define PHASE(kind, pid, ...) do { if (EN(kind) && IN(pid)) { _Pragma("nounroll") for (int rep_ = 0; rep_ <= (int)DUP(kind); ++rep_) { if (rep_) xcd_barrier(bar, g_wave); { const KArgP ap_ = kargs(); __VA_ARGS__ } } SEAM(pid); } } while (0)
    PHASE(0, 0, p0_prologue(ap_, lds, G, g_wave, rep_ ? MK_VAR : 0););

    for (int l = 0; l < 2; ++l) {
        const int pb = 1 + 10 * l;
        if (!(l == 1 && MK_NFUSE && G == 256 && MK_FP8_DDN && MK_XBF && !MK_FP8_QKV))
        PHASE(1, pb + 0, if (l == 0) norm_pass<true, false, MK_FP8_QKV ? 2 : 0>(ap_, l, 0, A_.in[I_X], lds, G, g_wave); else norm_pass<false, false, MK_FP8_QKV ? 2 : 0, MK_XBF != 0>(ap_, l, 0, MK_XBF ? (const void*)WSP(bf16_t, WS_XR) : (const void*)A_.out, lds, G, g_wave););
        PHASE(2, pb + 1,
            constexpr int CV_P0END = CV_WOUT0 + (int)((long)(CV_END - CV_WOUT0) * MK_CVP0 / 100), CV_SPLIT = CV_P0END + (CV_END - CV_P0END) / 2;
            static_assert(CV_SPLIT >= CV_MG, "everything used before the MoE is converted in the prologue or in layer 0");
            const int jx = (int)blockIdx.x >> 3; const int xx = (int)blockIdx.x & 7;
            const bool cvwg = MK_CVSPLIT && G == 256 && (jx & 3) == 3;
            const int gG = (MK_CVSPLIT && G == 256) ? 192 : G; const int gc = (MK_CVSPLIT && G == 256) ? (jx - (jx >> 2)) * 8 + xx : (int)blockIdx.x;
            if (cvwg) { if (rep_ == 0) { convert_items(ap_, lds, (jx >> 2) * 8 + xx, 64, g_wave, l == 0 ? CV_P0END : CV_SPLIT, l == 0 ? CV_SPLIT : CV_END);
                if (MK_VAR == 20) { __syncthreads(); convert_items(ap_, lds, (jx >> 2) * 8 + xx, 64, g_wave, l == 0 ? CV_P0END : CV_SPLIT, l == 0 ? CV_SPLIT : CV_END); } } }
            else {
                pg8::Gemm g{WSP(bf16_t, WS_H), WSP(bf16_t, WS_WIN) + (size_t)l * IN_W * DM, 2 * DM}; pg8::DenseOrder S; S.init(M / 256, IN_W / 256, gG, gc, MK_WGM_IN);
#if MK_UFUSE
                pg8::EpiInProj E{WSP(bf16_t, WS_P)};
                pg8::gemm_phase<pg8::EpiInProj, pg8::DenseOrder, true, true, false>(lds, g, S, E, g_wave);
#else
                pg8::EpiStoreBf16 E{WSP(bf16_t, WS_P), IN_W, 0, 1.0f};
                pg8::gemm_phase<pg8::EpiStoreBf16, pg8::DenseOrder, true, true, false>(lds, g, S, E, g_wave);
#endif
            }
            if (!MK_CVSPLIT && l == 0 && rep_ == 0) { }
            );
        PHASE(3, pb + 2, prep_pass(ap_, l, lds, G, g_wave); if (MK_VAR == 21) { for (int xb = 0; xb < 9; ++xb) xcd_barrier(bar, g_wave); });
        PHASE(4, pb + 3,
            const float* aog = A_.in[I_AOG] + (size_t)l * 1024; const bf16_t* Qm = WSP(bf16_t, WS_Q); const bf16_t* KVm = WSP(bf16_t, WS_KV); bf16_t* MIX = WSP(bf16_t, WS_MIX);
            for (int i = 0; ; ++i) { const int L = i * G + (int)blockIdx.x; if (L >= BATCH * NHEAD * (SEQ / 256)) break;
                const int b = L & 7; const int j = (L >> 3) & 31; const int kvh = L >> 8; const int h = kvh * 4 + (j >> 3); const int qb = j & 7;
                const bf16_t* Qb = Qm + (size_t)(b * SEQ + qb * 256) * attn::LDQ + h * HD;
                const bf16_t* Kh = KVm + (size_t)(b * SEQ) * attn::LDKV + kvh * HD;
                const bf16_t* Vh = KVm + (size_t)(b * SEQ) * attn::LDKV + 256 + kvh * HD;
                bf16_t* Ob = MIX + (size_t)(b * SEQ + qb * 256) * DM + h * HD;
                attn::attn_unit(Qb, Kh, Vh, Ob, aog + h * HD, SEQ, (char*)lds_raw, g_wave);
                __syncthreads();
            });
        PHASE(5, pb + 4,
            pg8::Gemm g{WSP(bf16_t, WS_MIX), WSP(bf16_t, WS_WOUT) + (size_t)l * DM * DM, 2 * DM}; pg8::DenseOrder S; S.init(M / 256, DM / 256, G, (int)blockIdx.x, MK_WGM_OUT);
            const float* g1 = WSP(float, WS_MODF) + (size_t)l * 8 * MODW + 2 * DM;
#if MK_XBF
            if (l == 0 && MK_NFUSE && G == 256 && MK_WGM_OUT == 4) {
                pg8::EpiResidNorm<true, MK_FP8_DUP != 0> E{A_.in[I_X], WSP(bf16_t, WS_XR), g1, 1.0f, A_.in[I_N2G], WSP(float, WS_MODF), 3 * DM, 4 * DM,
                    WSP(void, WS_H), WSP(float, WS_XS), WSP(unsigned, WS_CTL) + CW_NCNT, barw + XB_TMO, lds + RING_BYTES};
                pg8::gemm_phase<pg8::EpiResidNorm<true, MK_FP8_DUP != 0>, pg8::DenseOrder, true, true, false>(lds, g, S, E, g_wave); }
            else if (l == 0) { pg8::EpiResidBf<true> E{A_.in[I_X], WSP(bf16_t, WS_XR), g1, 1.0f}; pg8::gemm_phase<pg8::EpiResidBf<true>, pg8::DenseOrder, true, true, false>(lds, g, S, E, g_wave); }
            else { pg8::EpiResidBf<false> E{WSP(bf16_t, WS_XR), WSP(bf16_t, WS_XR), g1, 1.0f}; pg8::gemm_phase<pg8::EpiResidBf<false>, pg8::DenseOrder, true, true, false>(lds, g, S, E, g_wave); }
#else
            const float* xin = l ? A_.out : A_.in[I_X];
            pg8::EpiResid E{xin, A_.out, g1, 1.0f};
            pg8::gemm_phase<pg8::EpiResid, pg8::DenseOrder, true, true, false>(lds, g, S, E, g_wave);
#endif
            );
        if (!(l == 0 && MK_NFUSE && G == 256 && MK_WGM_OUT == 4))
        PHASE(6, pb + 5, const void* xr2 = MK_XBF ? (const void*)WSP(bf16_t, WS_XR) : (const void*)A_.out; if (l == 0) norm_pass<false, false, MK_FP8_DUP ? 1 : 0, MK_XBF != 0>(ap_, l, 1, xr2, lds, G, g_wave); else norm_pass<false, true, MK_FP8_MOE ? 1 : 0, MK_XBF != 0>(ap_, l, 1, xr2, lds, G, g_wave););
        if (l == 0) {
            PHASE(8, pb + 7,
                pg8::DenseOrder S; S.init(M / 256, 2 * FFD / 256, G, (int)blockIdx.x, MK_WGM_UP);
#if MK_FP8_DUP
                pg8::Gemm g{WSP(void, WS_H), WSP(void, WS_DGU), DM};
                pg8::EpiSwiGLU8T<MK_FP8_DDN != 0> E{WSP(void, WS_HID), FFD, FP8_DESCALE, MK_FP8_DDN ? FP8_ASCALE : 1.0f};
                pg8::gemm_phase<pg8::EpiSwiGLU8T<MK_FP8_DDN != 0>, pg8::DenseOrder, true, true, false, 0, true>(lds, g, S, E, g_wave);
#else
                pg8::Gemm g{WSP(bf16_t, WS_H), WSP(bf16_t, WS_DGU), 2 * DM};
                pg8::EpiSwiGLU E{WSP(bf16_t, WS_HID), FFD};
                pg8::gemm_phase<pg8::EpiSwiGLU, pg8::DenseOrder, true, true, false>(lds, g, S, E, g_wave);
#endif
                );
            PHASE(9, pb + 8,
                pg8::DenseOrder S; S.init(M / 256, DM / 256, G, (int)blockIdx.x, (MK_NFUSE && G == 256) ? 4 : MK_WGM_DN);
#if MK_FP8_DDN && MK_XBF
                pg8::Gemm g{WSP(void, WS_HID), WSP(void, WS_DDN), FFD};
                if (MK_NFUSE && G == 256) {
                    pg8::EpiResidNorm<false, false> E{WSP(bf16_t, WS_XR), WSP(bf16_t, WS_XR), WSP(float, WS_MODF) + (size_t)l * 8 * MODW + 5 * DM, FP8_DESCALE, A_.in[I_N1G] + DM, WSP(float, WS_MODF) + (size_t)8 * MODW, 0, DM,
                        WSP(void, WS_H), WSP(float, WS_XS) + 64 * 256 * 8, WSP(unsigned, WS_CTL) + CW_NCNT + 4096, barw + XB_TMO, lds + RING_BYTES};
                    pg8::gemm_phase<pg8::EpiResidNorm<false, false>, pg8::DenseOrder, true, true, false, 0, true>(lds, g, S, E, g_wave);
                } else {
                pg8::EpiResidBf<false> E{WSP(bf16_t, WS_XR), WSP(bf16_t, WS_XR), WSP(float, WS_MODF) + (size_t)l * 8 * MODW + 5 * DM, FP8_DESCALE};
                pg8::gemm_phase<pg8::EpiResidBf<false>, pg8::DenseOrder, true, true, false, 0, true>(lds, g, S, E, g_wave); }
#elif MK_FP8_DDN
                pg8::Gemm g{WSP(void, WS_HID), WSP(void, WS_DDN), FFD};
                pg8::EpiResid E{A_.out, A_.out, WSP(float, WS_MODF) + (size_t)l * 8 * MODW + 5 * DM, FP8_DESCALE};
                pg8::gemm_phase<pg8::EpiResid, pg8::DenseOrder, true, true, false, 0, true>(lds, g, S, E, g_wave);
#else
                pg8::Gemm g{WSP(bf16_t, WS_HID), WSP(bf16_t, WS_DDN), 2 * FFD};
                pg8::EpiResid E{A_.out, A_.out, WSP(float, WS_MODF) + (size_t)l * 8 * MODW + 5 * DM, 1.0f};
                pg8::gemm_phase<pg8::EpiResid, pg8::DenseOrder, true, true, false>(lds, g, S, E, g_wave);
#endif
                );
        } else {
            PHASE(7, pb + 6, route_pass(ap_, lds, G, g_wave););
            PHASE(10, pb + 7,
                const int* tsv = WSP(const int, WS_ROUTE + RT_TS);
                pg8::MoeOrder S; S.init(RFL(tsv[8]), 2 * FFE / 256, G, (int)blockIdx.x, MK_WGM_UP);
                S.t1 = RFL(tsv[1]); S.t2 = RFL(tsv[2]); S.t3 = RFL(tsv[3]); S.t4 = RFL(tsv[4]); S.t5 = RFL(tsv[5]); S.t6 = RFL(tsv[6]); S.t7 = RFL(tsv[7]); S.rowlist = WSP(const int, WS_ROUTE + RT_ROWLIST);
#if MK_FP8_MOE
                pg8::Gemm g{WSP(void, WS_H), WSP(void, WS_MGU), DM};
                pg8::EpiSwiGLU8 E{WSP(unsigned char, WS_HID), FFE, FP8_DESCALE, FP8_ASCALE};
                pg8::gemm_phase<pg8::EpiSwiGLU8, pg8::MoeOrder, true, true, true, 0, true>(lds, g, S, E, g_wave);
#else
                pg8::Gemm g{WSP(void, WS_H), WSP(void, WS_MGU), 2 * DM};
                pg8::EpiSwiGLU E{WSP(bf16_t, WS_HID), FFE};
                pg8::gemm_phase<pg8::EpiSwiGLU, pg8::MoeOrder, true, true, true>(lds, g, S, E, g_wave);
#endif
                );
            PHASE(11, pb + 8,
                const int* tsv = WSP(const int, WS_ROUTE + RT_TS);
                pg8::MoeOrder S; S.init(RFL(tsv[8]), DM / 256, G, (int)blockIdx.x, MK_WGM_DN);
                S.t1 = RFL(tsv[1]); S.t2 = RFL(tsv[2]); S.t3 = RFL(tsv[3]); S.t4 = RFL(tsv[4]); S.t5 = RFL(tsv[5]); S.t6 = RFL(tsv[6]); S.t7 = RFL(tsv[7]); S.rowlist = nullptr;
#if MK_FP8_MOE && MK_Y8
                pg8::Gemm g{WSP(void, WS_HID), WSP(void, WS_MDN), FFE};
                pg8::EpiStoreFp8 E{WSP(unsigned char, WS_Y), DM, FP8_DESCALE * FP8_YSCALE};
                pg8::gemm_phase<pg8::EpiStoreFp8, pg8::MoeOrder, true, true, false, 0, true>(lds, g, S, E, g_wave);
#elif MK_FP8_MOE
                pg8::Gemm g{WSP(void, WS_HID), WSP(void, WS_MDN), FFE};
                pg8::EpiStoreBf16T<true> E{WSP(bf16_t, WS_Y), DM, 0, FP8_DESCALE};
                pg8::gemm_phase<pg8::EpiStoreBf16T<true>, pg8::MoeOrder, true, true, false, 0, true>(lds, g, S, E, g_wave);
#else
                pg8::Gemm g{WSP(void, WS_HID), WSP(void, WS_MDN), 2 * FFE};
                pg8::EpiStoreBf16 E{WSP(bf16_t, WS_Y), DM, 0, 1.0f};
                pg8::gemm_phase<pg8::EpiStoreBf16, pg8::MoeOrder, true, true, false>(lds, g, S, E, g_wave);
#endif
                );
            PHASE(12, pb + 9, combine_pass(ap_, l, G, g_wave););
        }
    }
#undef PHASE
#undef A_
#undef WSP
#undef IN
#undef SEAM
}

extern "C" void kernel_launch(void* const* d_in, const int* in_sizes, int n_in, void* d_out, int out_size, void* d_ws, size_t ws_size, hipStream_t stream) {
    static int grid = 0;
    if (grid == 0) {
        if (n_in != 20 || in_sizes[0] != M * DM || out_size != M * DM || ws_size < WS_END) { fprintf(stderr, "kernel_launch: unexpected shapes (n_in %d in0 %d out %d ws %zu need %zu); nothing launched\n", n_in, n_in > 0 ? in_sizes[0] : -1, out_size, ws_size, (size_t)WS_END); grid = -1; return; }
        int dev = 0, cus = 0, per_cu = 0;
        if (hipGetDevice(&dev) != hipSuccess || hipDeviceGetAttribute(&cus, hipDeviceAttributeMultiprocessorCount, dev) != hipSuccess) { grid = -1; return; }
        if (hipFuncSetAttribute((const void*)mk_fwd, hipFuncAttributeMaxDynamicSharedMemorySize, LDS_BYTES) != hipSuccess) { fprintf(stderr, "kernel_launch: hipFuncSetAttribute failed\n"); grid = -1; return; }
        if (hipOccupancyMaxActiveBlocksPerMultiprocessor(&per_cu, (const void*)mk_fwd, 512, LDS_BYTES) != hipSuccess || per_cu < 1) fprintf(stderr, "kernel_launch: occupancy query says %d blocks per CU\n", per_cu);
        (void)hipGetLastError();
        grid = cus < 256 ? cus : 256;
    }
    if (grid < 0) return;
    if (hipMemsetAsync((char*)d_ws + WS_CTL, 0, CTL_ZERO_BYTES, stream) != hipSuccess) return;
    Args a{};
    for (int i = 0; i < 20; ++i) a.in[i] = (const float*)d_in[i];
    a.out = (float*)d_out; a.ws = (unsigned char*)d_ws;
#if MK_MULTI
    for (int p = 0; p < NPHASE; ++p) {
        if (p == 7 || p == 10) continue;
        a.ph_lo = p; a.ph_hi = p + 1;
        hipLaunchKernelGGL(mk_fwd, dim3(grid), dim3(512), LDS_BYTES, stream, a);
    }
#else
    a.ph_lo = 0; a.ph_hi = NPHASE;
    hipLaunchKernelGGL(mk_fwd, dim3(grid), dim3(512), LDS_BYTES, stream, a);
#endif
    const hipError_t le = hipPeekAtLastError();
    if (le != hipSuccess) fprintf(stderr, "kernel_launch: launch failed: %s\n", hipGetErrorName(le));
}
```
